# Optimizing an MI355X kernel written in HIP

```python
import math
import jax, jax.numpy as jnp
from jax import lax
import numpy as np

D_MODEL = 1024
BATCH = 8
SEQ = 2048
DEPTH = 2
DEC_BATCH = 16
DEC_SEQ = 16
PAST_LEN = 1024

CHUNK = 64
N_HEADS = 8
HEAD_DIM = 64
V_DIM = 2 * HEAD_DIM
W_ATTN = N_HEADS * V_DIM
QK_COLS = 2 * N_HEADS * HEAD_DIM
GROUP_CH = 16
W_SSM = 1024
N_GROUPS = W_SSM // GROUP_CH
STATE_DIM = 64
Q_BLOCK = 128
EPS = 1e-6
IN_COLS = 2 * QK_COLS + 2 * W_ATTN + 2 * W_SSM + 2 * D_MODEL
IN_SPLITS = (QK_COLS, 2 * QK_COLS, 2 * QK_COLS + W_ATTN, 2 * QK_COLS + 2 * W_ATTN,
             2 * QK_COLS + 2 * W_ATTN + W_SSM, 2 * QK_COLS + 2 * W_ATTN + 2 * W_SSM)

kernel_name = "hybrid_diffattn_s5_streaming_step"


def rmsnorm(x, g):
    x32 = x.astype(jnp.float32)
    y = x32 * lax.rsqrt(jnp.mean(x32 * x32, axis=-1, keepdims=True) + EPS)
    return (y * g.astype(jnp.float32)).astype(x.dtype)


def alibi_slopes():
    return jnp.exp2(-8.0 * (jnp.arange(N_HEADS, dtype=jnp.float32) + 1.0) / N_HEADS)


def diff_attn_core(q, k, v, q_pos, k_pos, lam, slopes):
    s = jnp.einsum('bqmhd,bkmhd->bmhqk', q, k.astype(jnp.float32))
    dist = jnp.abs(q_pos[:, None] - k_pos[None, :]).astype(jnp.float32)
    allowed = (k_pos[None, :] // CHUNK) <= (q_pos[:, None] // CHUNK)
    s = s - slopes[:, None, None] * dist
    s = jnp.where(allowed, s, -jnp.inf)
    p = jax.nn.softmax(s, axis=-1)
    w = p[:, 0] - lam * p[:, 1]
    return jnp.einsum('bhqk,bkhe->bqhe', w, v.astype(jnp.float32))


def attn_prompt(q, k, v, lam, slopes):
    b, t = q.shape[0], q.shape[1]
    nb = t // Q_BLOCK
    qb = q.reshape(b, nb, Q_BLOCK, 2, N_HEADS, HEAD_DIM).transpose(1, 0, 2, 3, 4, 5)
    k_pos = jnp.arange(t)

    def one_block(args):
        q_blk, i = args
        q_pos = i * Q_BLOCK + jnp.arange(Q_BLOCK)
        return diff_attn_core(q_blk, k, v, q_pos, k_pos, lam, slopes)

    o = lax.map(one_block, (qb, jnp.arange(nb)))
    return o.transpose(1, 0, 2, 3, 4).reshape(b, t, N_HEADS, V_DIM)


def attn_sample(q, k, v, k_past, v_past, lam, slopes):
    t = q.shape[1]
    p_len = k_past.shape[1]
    k_all = jnp.concatenate([k_past.astype(k.dtype), k], axis=1)
    v_all = jnp.concatenate([v_past.astype(v.dtype), v], axis=1)
    q_pos = p_len + jnp.arange(t)
    k_pos = jnp.arange(p_len + t)
    return diff_attn_core(q, k_all, v_all, q_pos, k_pos, lam, slopes)


def s5_scan(u, h0_re, h0_im, lam_re, lam_im, log_dt, b_re, b_im, c_re, c_im, d_skip):
    b, t, _ = u.shape
    f32 = jnp.float32
    u32 = u.astype(f32).reshape(b, t, N_GROUPS, GROUP_CH)
    lr, li = lam_re.astype(f32), lam_im.astype(f32)
    dt = jnp.exp(log_dt.astype(f32))[:, None]
    mag = jnp.exp(lr * dt)
    ang = li * dt
    a_re, a_im = mag * jnp.cos(ang), mag * jnp.sin(ang)
    z_re, z_im = a_re - 1.0, a_im
    den = lr * lr + li * li
    w_re = (z_re * lr + z_im * li) / den
    w_im = (z_im * lr - z_re * li) / den
    br, bi = b_re.astype(f32), b_im.astype(f32)
    bb_re = w_re[..., None] * br - w_im[..., None] * bi
    bb_im = w_re[..., None] * bi + w_im[..., None] * br
    bu_re = jnp.einsum('btgn,gpn->btgp', u32, bb_re)
    bu_im = jnp.einsum('btgn,gpn->btgp', u32, bb_im)
    h0r, h0i = h0_re.astype(f32), h0_im.astype(f32)
    bu_re = bu_re.at[:, 0].add(a_re * h0r - a_im * h0i)
    bu_im = bu_im.at[:, 0].add(a_re * h0i + a_im * h0r)
    a_re_t = jnp.broadcast_to(a_re, (1, t, N_GROUPS, STATE_DIM))
    a_im_t = jnp.broadcast_to(a_im, (1, t, N_GROUPS, STATE_DIM))

    def combine(e1, e2):
        a1r, a1i, b1r, b1i = e1
        a2r, a2i, b2r, b2i = e2
        return (a1r * a2r - a1i * a2i, a1r * a2i + a1i * a2r,
                a2r * b1r - a2i * b1i + b2r, a2r * b1i + a2i * b1r + b2i)

    _, _, hr, hi = lax.associative_scan(combine, (a_re_t, a_im_t, bu_re, bu_im), axis=1)
    y = (jnp.einsum('btgp,gnp->btgn', hr, c_re.astype(f32))
         - jnp.einsum('btgp,gnp->btgn', hi, c_im.astype(f32)))
    y = y.reshape(b, t, W_SSM) + d_skip.astype(f32) * u32.reshape(b, t, W_SSM)
    return y.astype(u.dtype), hr[:, -1], hi[:, -1]


def mixer_layer(x, k_past, v_past, h0_re, h0_im, layer_idx,
                norm_g, w_in, q_norm_g, k_norm_g, lam_q1, lam_k1, lam_q2, lam_k2, subln_g,
                w_attn_proj, lam_re, lam_im, log_dt, b_re, b_im, c_re, c_im, d_skip,
                w_glu, b_glu, w_ssm_proj, w_out):
    b, t, _ = x.shape
    f32 = jnp.float32
    xn = rmsnorm(x, norm_g)
    h = xn @ w_in
    q, k, v, ga, u, gs, gl = jnp.split(h, IN_SPLITS, axis=-1)
    q = q.reshape(b, t, 2, N_HEADS, HEAD_DIM)
    k = k.reshape(b, t, 2, N_HEADS, HEAD_DIM)
    v = v.reshape(b, t, N_HEADS, V_DIM)
    q = rmsnorm(q, q_norm_g).astype(f32) * (HEAD_DIM ** -0.5)
    k = rmsnorm(k, k_norm_g)
    lam_init = 0.8 - 0.6 * math.exp(-0.3 * layer_idx)
    lam = (jnp.exp(jnp.sum(lam_q1.astype(f32) * lam_k1.astype(f32)))
           - jnp.exp(jnp.sum(lam_q2.astype(f32) * lam_k2.astype(f32))) + lam_init)
    slopes = alibi_slopes()
    if k_past is None:
        o = attn_prompt(q, k, v, lam, slopes)
    else:
        o = attn_sample(q, k, v, k_past, v_past, lam, slopes)
    o = rmsnorm(o, subln_g) * (1.0 - lam_init)
    o = o.reshape(b, t, W_ATTN).astype(x.dtype) * jax.nn.silu(ga)
    ya = o @ w_attn_proj
    ys, hr, hi = s5_scan(u, h0_re, h0_im, lam_re, lam_im, log_dt, b_re, b_im, c_re, c_im, d_skip)
    ys = jax.nn.gelu(ys)
    ys = ys * jax.nn.sigmoid(ys @ w_glu + b_glu)
    ys = (ys * jax.nn.silu(gs)) @ w_ssm_proj
    g_a, g_s = jnp.split(gl, 2, axis=-1)
    merged = jax.nn.sigmoid(g_a) * ya + jax.nn.sigmoid(g_s) * ys
    x = x + merged @ w_out
    return x, k, v, hr, hi


def setup_inputs(seed: int = 0) -> dict:
    key = jax.random.key(seed)
    ks = jax.random.split(key, 32)
    f32 = jnp.float32
    nrm = lambda k, s, sc: sc * jax.random.normal(k, s, f32)
    lam_im = (jnp.pi * jnp.arange(STATE_DIM, dtype=f32))[None, None, :] + nrm(ks[11], (DEPTH, N_GROUPS, STATE_DIM), 0.01)
    return {
        "x_prompt": nrm(ks[0], (BATCH, SEQ, D_MODEL), 1.0),
        "x_sample": nrm(ks[1], (DEC_BATCH, DEC_SEQ, D_MODEL), 1.0),
        "cache_k": nrm(ks[2], (DEPTH, DEC_BATCH, PAST_LEN, 2, N_HEADS, HEAD_DIM), 1.0),
        "cache_v": nrm(ks[3], (DEPTH, DEC_BATCH, PAST_LEN, N_HEADS, V_DIM), 1.0),
        "state_ssm_re": nrm(ks[4], (DEPTH, DEC_BATCH, N_GROUPS, STATE_DIM), 0.5),
        "state_ssm_im": nrm(ks[5], (DEPTH, DEC_BATCH, N_GROUPS, STATE_DIM), 0.5),
        "norm_g": 1.0 + nrm(ks[6], (DEPTH, D_MODEL), 0.02),
        "w_in": nrm(ks[7], (DEPTH, D_MODEL, IN_COLS), D_MODEL ** -0.5),
        "q_norm_g": 1.0 + nrm(ks[8], (DEPTH, HEAD_DIM), 0.02),
        "k_norm_g": 1.0 + nrm(ks[9], (DEPTH, HEAD_DIM), 0.02),
        "lam_q1": nrm(ks[12], (DEPTH, HEAD_DIM), 0.1),
        "lam_k1": nrm(ks[13], (DEPTH, HEAD_DIM), 0.1),
        "lam_q2": nrm(ks[14], (DEPTH, HEAD_DIM), 0.1),
        "lam_k2": nrm(ks[15], (DEPTH, HEAD_DIM), 0.1),
        "subln_g": 1.0 + nrm(ks[16], (DEPTH, V_DIM), 0.02),
        "w_attn_proj": nrm(ks[17], (DEPTH, W_ATTN, D_MODEL), W_ATTN ** -0.5),
        "ssm_lambda_re": -0.5 + nrm(ks[10], (DEPTH, N_GROUPS, STATE_DIM), 0.01),
        "ssm_lambda_im": lam_im,
        "ssm_log_dt": jax.random.uniform(ks[18], (DEPTH, N_GROUPS), f32, math.log(1e-3), math.log(1e-1)),
        "ssm_b_re": nrm(ks[19], (DEPTH, N_GROUPS, STATE_DIM, GROUP_CH), (2.0 * GROUP_CH) ** -0.5),
        "ssm_b_im": nrm(ks[20], (DEPTH, N_GROUPS, STATE_DIM, GROUP_CH), (2.0 * GROUP_CH) ** -0.5),
        "ssm_c_re": nrm(ks[21], (DEPTH, N_GROUPS, GROUP_CH, STATE_DIM), (2.0 * STATE_DIM) ** -0.5),
        "ssm_c_im": nrm(ks[22], (DEPTH, N_GROUPS, GROUP_CH, STATE_DIM), (2.0 * STATE_DIM) ** -0.5),
        "ssm_d": nrm(ks[23], (DEPTH, W_SSM), 1.0),
        "w_glu": nrm(ks[24], (DEPTH, W_SSM, W_SSM), W_SSM ** -0.5),
        "b_glu": nrm(ks[25], (DEPTH, W_SSM), 0.02),
        "w_ssm_proj": nrm(ks[26], (DEPTH, W_SSM, D_MODEL), W_SSM ** -0.5),
        "w_out": nrm(ks[27], (DEPTH, D_MODEL, D_MODEL), D_MODEL ** -0.5),
    }


def reference(x_prompt, x_sample, cache_k, cache_v, state_ssm_re, state_ssm_im,
              norm_g, w_in, q_norm_g, k_norm_g, lam_q1, lam_k1, lam_q2, lam_k2, subln_g,
              w_attn_proj, ssm_lambda_re, ssm_lambda_im, ssm_log_dt, ssm_b_re, ssm_b_im,
              ssm_c_re, ssm_c_im, ssm_d, w_glu, b_glu, w_ssm_proj, w_out):
    yp, ys = x_prompt, x_sample
    kp_l, vp_l, hrp_l, hip_l = [], [], [], []
    ks_l, vs_l, hrs_l, his_l = [], [], [], []
    zeros_h = jnp.zeros((x_prompt.shape[0], N_GROUPS, STATE_DIM), jnp.float32)
    for l in range(DEPTH):
        lw = (norm_g[l], w_in[l], q_norm_g[l], k_norm_g[l], lam_q1[l], lam_k1[l], lam_q2[l], lam_k2[l],
              subln_g[l], w_attn_proj[l], ssm_lambda_re[l], ssm_lambda_im[l], ssm_log_dt[l],
              ssm_b_re[l], ssm_b_im[l], ssm_c_re[l], ssm_c_im[l], ssm_d[l], w_glu[l], b_glu[l],
              w_ssm_proj[l], w_out[l])
        yp, kp, vp, hrp, hip = mixer_layer(yp, None, None, zeros_h, zeros_h, l, *lw)
        ys, kn, vn, hrs, his = mixer_layer(ys, cache_k[l], cache_v[l], state_ssm_re[l], state_ssm_im[l], l, *lw)
        kp_l.append(kp); vp_l.append(vp); hrp_l.append(hrp); hip_l.append(hip)
        ks_l.append(kn); vs_l.append(vn); hrs_l.append(hrs); his_l.append(his)
    return (yp, ys,
            jnp.stack(kp_l), jnp.stack(vp_l), jnp.stack(hrp_l), jnp.stack(hip_l),
            jnp.stack(ks_l), jnp.stack(vs_l), jnp.stack(hrs_l), jnp.stack(his_l))
```

```cpp
#include <hip/hip_runtime.h>
#include <cstdio>
#include <cstdint>

#define LAS __attribute__((address_space(3)))
#define GAS __attribute__((address_space(1)))
typedef unsigned short bf16_t;
typedef short bf16x8 __attribute__((ext_vector_type(8)));
typedef short s16x4 __attribute__((ext_vector_type(4)));
typedef float f32x2 __attribute__((ext_vector_type(2)));
typedef float f32x4 __attribute__((ext_vector_type(4)));
typedef float f32x16 __attribute__((ext_vector_type(16)));
typedef unsigned u32x2 __attribute__((ext_vector_type(2)));
typedef unsigned u32x4 __attribute__((ext_vector_type(4)));

constexpr int D = 1024, NB = 8, T = 2048, DEPTH = 2, DB = 16, DS = 16, PAST = 1024, NH = 8, HD = 64, VD = 128;
constexpr int MP = NB * T, MS = DB * DS, MT = MP + MS, INC = 8192;
constexpr int NG = 64, GC = 16, SP = 64, LC = 32, NPAIR = MP / LC;
constexpr int KX = LC * GC + 2 * SP;
constexpr float EPS = 1e-6f, LOG2E = 1.4426950408889634f;
constexpr int NTS = PAST / 64 + 1;
constexpr size_t O_Y = 0, O_KP = 17039360, O_VP = 50593792, O_HRP = 84148224, O_HIP = 84213760, O_KS = 84279296, O_VS = 84803584, O_HRS = 85327872, O_HIS = 85458944, O_END = 85590016;
constexpr size_t MiB = 1u << 20;
constexpr size_t WS_CTL = 0, CTL_ZERO_BYTES = 64 * 1024, WS_SCAL = 1 * MiB, WS_WIN = 2 * MiB, WS_WSM = 34 * MiB, WS_BT2 = 50 * MiB, WS_BT1 = 90 * MiB,
                 WS_XB = 99 * MiB  , WS_QB = 132 * MiB  , WS_KTP = 165 * MiB, WS_VTP = 197 * MiB  , WS_KTS = 230 * MiB, WS_VTS = 264 * MiB,
                 WS_GA = 298 * MiB  , WS_GS = 331 * MiB, WS_GL = 364 * MiB, WS_UX = 429 * MiB, WS_HF = 469 * MiB, WS_SSQ = 485 * MiB, WS_US = 487 * MiB, WS_END = 488 * MiB;
constexpr int SC_A32 = 1024;

__device__ __forceinline__ unsigned pk2bf(float lo, float hi) { typedef __bf16 b2 __attribute__((ext_vector_type(2))); f32x2 v = {lo, hi}; b2 b = __builtin_convertvector(v, b2); return __builtin_bit_cast(unsigned, b); }
__device__ __forceinline__ u32x4 pk8bf(const float* v) { u32x4 w; w.x = pk2bf(v[0], v[1]); w.y = pk2bf(v[2], v[3]); w.z = pk2bf(v[4], v[5]); w.w = pk2bf(v[6], v[7]); return w; }
__device__ __forceinline__ void unpk8bf(u32x4 w, float* v) {
    v[0] = __uint_as_float(w.x << 16); v[1] = __uint_as_float(w.x & 0xffff0000u); v[2] = __uint_as_float(w.y << 16); v[3] = __uint_as_float(w.y & 0xffff0000u);
    v[4] = __uint_as_float(w.z << 16); v[5] = __uint_as_float(w.z & 0xffff0000u); v[6] = __uint_as_float(w.w << 16); v[7] = __uint_as_float(w.w & 0xffff0000u); }
__device__ __forceinline__ float bf2f(bf16_t x) { return __uint_as_float((unsigned)x << 16); }
__device__ __forceinline__ bf16_t f2bf(float f) { return (bf16_t)(pk2bf(f, 0.f) & 0xffffu); }
__device__ __forceinline__ float sigmoidf_(float x) { return __builtin_amdgcn_rcpf(1.0f + __builtin_amdgcn_exp2f(-LOG2E * x)); }
__device__ __forceinline__ float siluf_(float x) { return x * sigmoidf_(x); }
__device__ __forceinline__ float geluf_(float x) { return x * sigmoidf_(1.5957691216057308f * (x + 0.044715f * x * x * x)); }
#define LDS_WAIT() asm volatile("s_waitcnt lgkmcnt(0)" ::: "memory")
#define VM_WAIT() asm volatile("s_waitcnt vmcnt(0)" ::: "memory")

namespace pg8 {
constexpr int BM = 256, BK = 64, HALF = 128, HTB = HALF * BK * 2, STAGE_BYTES = 8 * HTB, NXCD = 8, WGM = 8;
__device__ __forceinline__ int lds_byte(int r, int c) { const int st = (r >> 4) * 2 + (c >> 5), rr = r & 15, cc = c & 31, ob = rr * 64 + cc * 2; return st * 1024 + (ob ^ (((ob >> 9) & 1) << 5)); }
__device__ __forceinline__ void stage_rc(int b, int& R, int& C) { const int st = b / 1024, sb = b % 1024, swz = sb ^ (((sb >> 9) & 1) << 5); R = (st >> 1) * 16 + swz / 64; C = (st & 1) * 32 + (swz % 64) / 2; }
__device__ __forceinline__ int perm32(int rho) { const int n = rho >> 4, i = rho & 15; return 8 * (i >> 2) + 4 * n + (i & 3); }

struct Unit { int pm, pn, grp; };
struct Gemm { const bf16_t* A; const bf16_t* Bt; int lda, ldb, K; size_t gsA, gsB; };

struct TileOrder {
    int nM, nN, per, total, G, c;
    __device__ void init(int nM_, int nN_, int nG_, int G_, int c_) { nM = nM_; nN = nN_; per = nM_ * nN_; total = per * nG_; G = G_; c = c_; }
    __device__ bool next(int i, Unit& u) const {
        if (c < 0) return false;
        const long L = (long)i * G + c; if (L >= total) return false;
        int wgid = (int)L; { const int q = total / NXCD, r = total % NXCD, xcd = wgid % NXCD, off = wgid / NXCD; wgid = (xcd < r ? xcd * (q + 1) : r * (q + 1) + (xcd - r) * q) + off; }
        u.grp = wgid / per; const int rem = wgid % per;
        const int nig = WGM * nN, gid = rem / nig, fm = gid * WGM, gsz = (nM - fm) < WGM ? (nM - fm) : WGM;
        u.pm = fm + ((rem % nig) % gsz); u.pn = (rem % nig) / gsz; return true;
    }
};

template <class Epi>
__device__ __forceinline__ void gemm_phase(LAS unsigned char* lds, const Gemm g, const TileOrder& S, const Epi& E) {
    int tid = threadIdx.x; asm volatile("" : "+v"(tid));
    const int wid = __builtin_amdgcn_readfirstlane(tid >> 6), lane = tid & 63, wr = wid >> 2, wc = wid & 3, fr = lane & 15, fq = lane >> 4;
    const int nt = g.K / BK;
    unsigned voffA[2], voffB[2];
#pragma unroll
    for (int i = 0; i < 2; ++i) { int R, C; stage_rc(tid * 16 + i * 8192, R, C); const int Rb = (R & ~31) + perm32(R & 31);
        voffA[i] = (unsigned)(R * g.lda + C) * 2u; voffB[i] = (unsigned)(Rb * g.ldb + C) * 2u; }
    const size_t kstep = (size_t)(BK * 2);
    const size_t hstepA = (size_t)HALF * g.lda * 2, hstepB = (size_t)HALF * g.ldb * 2;
    const unsigned ldsw = (unsigned)wid * 1024u;
    const int aoff = lds_byte(wr * 64 + fr, fq * 8), boff = lds_byte(wc * 32 + fr, fq * 8);
#define PG8_SA(b, h) (((b) * 2 + (h)) * HTB)
#define PG8_SB(b, h) ((4 + (b) * 2 + (h)) * HTB)
#define PG8_STAGE(bufoff, gbase, voff) do { _Pragma("unroll") for (int _i = 0; _i < 2; ++_i) \
        __builtin_amdgcn_global_load_lds((const unsigned*)((const char*)(gbase) + (voff)[_i]), (LAS unsigned*)(lds + (bufoff) + ldsw + _i * 8192), 16, 0, 0); } while (0)
#define PG8_LDA(dst, b, h) do { _Pragma("unroll") for (int m = 0; m < 4; ++m) _Pragma("unroll") for (int k = 0; k < 2; ++k) dst[m][k] = *(const LAS bf16x8*)(lds + PG8_SA(b, h) + aoff + m * 2048 + k * 1024); } while (0)
#define PG8_LDB(dst, b, h) do { _Pragma("unroll") for (int n = 0; n < 2; ++n) _Pragma("unroll") for (int k = 0; k < 2; ++k) dst[n][k] = *(const LAS bf16x8*)(lds + PG8_SB(b, h) + boff + n * 2048 + k * 1024); } while (0)
#define PG8_MMA(ai, bj, At, Bt) do { __builtin_amdgcn_s_setprio(1); _Pragma("unroll") for (int m = 0; m < 4; ++m) _Pragma("unroll") for (int n = 0; n < 2; ++n) _Pragma("unroll") for (int k = 0; k < 2; ++k) \
        acc[ai][bj][m][n] = __builtin_amdgcn_mfma_f32_16x16x32_bf16(Bt[n][k], At[m][k], acc[ai][bj][m][n], 0, 0, 0); __builtin_amdgcn_s_setprio(0); } while (0)
#define PG8_WAIT_V(n) asm volatile("s_waitcnt vmcnt(" #n ")" ::: "memory")
#define PG8_WAIT_L(n) asm volatile("s_waitcnt lgkmcnt(" #n ")" ::: "memory")
#define PG8_BAR __builtin_amdgcn_s_barrier()
#define PG8_SCHED __builtin_amdgcn_sched_barrier(0)
#define PG8_ABASE(u) ((const char*)g.A + ((size_t)(u).grp * g.gsA + (size_t)(u).pm * BM * g.lda) * 2)
#define PG8_BBASE(u) ((const char*)g.Bt + ((size_t)(u).grp * g.gsB + (size_t)(u).pn * BM * g.ldb) * 2)
    Unit cur, nxt; int ui = 0;
    if (!S.next(0, cur)) return;
    f32x4 acc[2][2][4][2];
#pragma unroll
    for (int a = 0; a < 2; ++a)
#pragma unroll
        for (int b = 0; b < 2; ++b)
#pragma unroll
            for (int m = 0; m < 4; ++m)
#pragma unroll
                for (int n = 0; n < 2; ++n) acc[a][b][m][n] = (f32x4){0.f, 0.f, 0.f, 0.f};
    bf16x8 At[4][2], B0[2][2], B1[2][2];
    const char* cA = PG8_ABASE(cur); const char* cB = PG8_BBASE(cur);
    PG8_STAGE(PG8_SB(0, 0), cB, voffB); PG8_STAGE(PG8_SB(0, 1), cB + hstepB, voffB); PG8_STAGE(PG8_SA(0, 0), cA, voffA); PG8_STAGE(PG8_SA(0, 1), cA + hstepA, voffA);
    if (wr == 1) PG8_BAR;
    PG8_WAIT_V(2); PG8_BAR;
    PG8_STAGE(PG8_SB(1, 0), cB + kstep, voffB); PG8_STAGE(PG8_SA(1, 0), cA + kstep, voffA); PG8_STAGE(PG8_SB(1, 1), cB + hstepB + kstep, voffB);
    PG8_WAIT_V(6); PG8_BAR;
    for (;;) {
        const bool has_next = S.next(ui + 1, nxt);
        const char* nA = has_next ? PG8_ABASE(nxt) : cA; const char* nB = has_next ? PG8_BBASE(nxt) : cB;
        for (int t = 0; t < nt; t += 2) {
            const bool last = (t == nt - 2);
            const char* a1 = cA + (size_t)(t + 1) * kstep;
            const char* a2 = last ? nA : cA + (size_t)(t + 2) * kstep; const char* b2 = last ? nB : cB + (size_t)(t + 2) * kstep;
            const char* a3 = a2 + kstep; const char* b3 = b2 + kstep;
            PG8_LDB(B0, 0, 0); PG8_LDB(B1, 0, 1); PG8_SCHED; PG8_LDA(At, 0, 0); PG8_STAGE(PG8_SA(1, 1), a1 + hstepA, voffA);
            PG8_WAIT_V(8); PG8_WAIT_L(0); PG8_BAR; PG8_MMA(0, 0, At, B0); PG8_MMA(0, 1, At, B1); PG8_BAR; PG8_SCHED;
            PG8_LDA(At, 0, 1); PG8_STAGE(PG8_SB(0, 0), b2, voffB); PG8_STAGE(PG8_SB(0, 1), b2 + hstepB, voffB); PG8_STAGE(PG8_SA(0, 0), a2, voffA);
            PG8_WAIT_V(8); PG8_WAIT_L(0); PG8_BAR; PG8_MMA(1, 0, At, B0); PG8_MMA(1, 1, At, B1); PG8_BAR; PG8_SCHED;
            PG8_LDB(B0, 1, 0); PG8_LDB(B1, 1, 1); PG8_SCHED; PG8_LDA(At, 1, 0); PG8_STAGE(PG8_SA(0, 1), a2 + hstepA, voffA);
            PG8_WAIT_V(8); PG8_WAIT_L(0); PG8_BAR; PG8_MMA(0, 0, At, B0); PG8_MMA(0, 1, At, B1); PG8_BAR; PG8_SCHED;
            PG8_LDA(At, 1, 1); PG8_STAGE(PG8_SB(1, 0), b3, voffB); PG8_STAGE(PG8_SB(1, 1), b3 + hstepB, voffB); PG8_STAGE(PG8_SA(1, 0), a3, voffA);
            PG8_WAIT_V(8); PG8_WAIT_L(0); PG8_BAR; PG8_MMA(1, 0, At, B0); PG8_MMA(1, 1, At, B1); PG8_BAR; PG8_SCHED;
        }
        if (wr == 0) PG8_BAR;
        E(acc, cur, wr, wc, fr, fq);
        if (!has_next) break;
#pragma unroll
        for (int a = 0; a < 2; ++a)
#pragma unroll
            for (int b = 0; b < 2; ++b)
#pragma unroll
                for (int m = 0; m < 4; ++m)
#pragma unroll
                    for (int n = 0; n < 2; ++n) acc[a][b][m][n] = (f32x4){0.f, 0.f, 0.f, 0.f};
        cur = nxt; cA = nA; cB = nB; ++ui;
        if (wr == 1) PG8_BAR;
    }
    PG8_WAIT_V(0);
    PG8_BAR;
#undef PG8_SA
#undef PG8_SB
#undef PG8_STAGE
#undef PG8_LDA
#undef PG8_LDB
#undef PG8_MMA
#undef PG8_WAIT_V
#undef PG8_WAIT_L
#undef PG8_BAR
#undef PG8_SCHED
#undef PG8_ABASE
#undef PG8_BBASE
}
}
using pg8::Unit;

#define EPI_FOR_ROWS _Pragma("unroll") for (int ai = 0; ai < 2; ++ai) _Pragma("unroll") for (int m = 0; m < 4; ++m) for (bool _once = (__builtin_amdgcn_sched_barrier(0), true); _once; _once = false)
#define EPI_ROW (u.pm * 256 + ai * 128 + wr * 64 + m * 16 + fr)
#define EPI_GET8(v, bj) float v[8] = {acc[ai][bj][m][0][0], acc[ai][bj][m][0][1], acc[ai][bj][m][0][2], acc[ai][bj][m][0][3], acc[ai][bj][m][1][0], acc[ai][bj][m][1][1], acc[ai][bj][m][1][2], acc[ai][bj][m][1][3]}
typedef const f32x4 (&AccRef)[2][2][4][2];
__device__ __forceinline__ void st8f(float* p, const float* v) { *(f32x4*)p = (f32x4){v[0], v[1], v[2], v[3]}; *(f32x4*)(p + 4) = (f32x4){v[4], v[5], v[6], v[7]}; }
__device__ __forceinline__ void ld8f(const float* p, float* v) { const f32x4 a = *(const f32x4*)p, b = *(const f32x4*)(p + 4); v[0] = a[0]; v[1] = a[1]; v[2] = a[2]; v[3] = a[3]; v[4] = b[0]; v[5] = b[1]; v[6] = b[2]; v[7] = b[3]; }
__device__ __forceinline__ void ld8b(const bf16_t* p, float* v) { unpk8bf(*(const u32x4*)p, v); }
__device__ __forceinline__ void st8b(bf16_t* p, const float* v) { *(u32x4*)p = pk8bf(v); }

__device__ __forceinline__ float row_rinv(const float* ssq, int row) {
    const f32x4* s = (const f32x4*)(ssq + (size_t)row * 16); const f32x4 a = s[0], b = s[1], c = s[2], d = s[3];
    const float t = ((a[0] + a[1]) + (a[2] + a[3])) + ((b[0] + b[1]) + (b[2] + b[3])) + ((c[0] + c[1]) + (c[2] + c[3])) + ((d[0] + d[1]) + (d[2] + d[3]));
    return __builtin_amdgcn_rsqf(t * (1.0f / D) + EPS); }
struct EpiIn {
    const float* ssq; const float* qg; const float* kg;
    float *okp, *ovp, *oks, *ovs;
    bf16_t *QB, *KTP, *VTP, *KTS, *VTS, *GA, *UX, *GS, *GL; float* US;
    __device__ __forceinline__ void operator()(AccRef acc, const Unit& u, int wr, int wc, int fr, int fq) const {
        const int pn = u.pn; const bool smp = (u.pm == MP / 256);
        if (pn < 8) {
            const bool isk = pn >= 4; const float* g = isk ? kg : qg; const float scale = isk ? 1.0f : 0.125f * LOG2E;
            float gv[2][8];
#pragma unroll
            for (int bj = 0; bj < 2; ++bj) ld8f(g + 32 * bj + 8 * fq, gv[bj]);
            const int ct = (isk ? pn - 4 : pn) * 256 + 64 * wc + 8 * fq;
            const int mapi = ct >> 9, head = (ct >> 6) & 7;
            EPI_FOR_ROWS { const int row = EPI_ROW; const float ri = row_rinv(ssq, row);
                EPI_GET8(v0, 0); EPI_GET8(v1, 1); float s = 0.f;
#pragma unroll
                for (int j = 0; j < 8; ++j) { v0[j] *= ri; v1[j] *= ri; s += v0[j] * v0[j] + v1[j] * v1[j]; }
                s += __shfl_xor(s, 16); s += __shfl_xor(s, 32);
                const float rn = __builtin_amdgcn_rsqf(s * (1.0f / HD) + EPS) * scale;
#pragma unroll
                for (int j = 0; j < 8; ++j) { v0[j] *= rn * gv[0][j]; v1[j] *= rn * gv[1][j]; }
                if (!isk) { st8b(QB + (size_t)row * D + ct, v0); st8b(QB + (size_t)row * D + ct + 32, v1); }
                else {
                    float* o = smp ? oks + (size_t)(row - MP) * D + ct : okp + (size_t)row * D + ct; st8f(o, v0); st8f(o + 32, v1);
                    bf16_t* img; int kv;
                    if (smp) { const int rs = row - MP, b = rs >> 4; kv = rs & 15; img = KTS + ((size_t)((b * NH + head) * 2 + mapi) * NTS + (NTS - 1)) * 4096; }
                    else { const int b = row >> 11, t = row & (T - 1); kv = t & 63; img = KTP + ((size_t)((b * NH + head) * 2 + mapi) * (T / 64) + (t >> 6)) * 4096; }
                    bf16_t* p = img + (fq >> 1) * 1024 + (fq & 1) * 512 + kv * 8; st8b(p, v0); st8b(p + 2048, v1);
                }
            }
        } else if (pn < 12) {
            EPI_FOR_ROWS { const int row = EPI_ROW; const float ri = row_rinv(ssq, row);
#pragma unroll
                for (int bj = 0; bj < 2; ++bj) { EPI_GET8(v, bj);
#pragma unroll
                    for (int j = 0; j < 8; ++j) v[j] *= ri;
                    const int ct = (pn - 8) * 256 + 128 * bj + 32 * wc + 8 * fq, head = ct >> 7;
                    st8f((smp ? ovs + (size_t)(row - MP) * D : ovp + (size_t)row * D) + ct, v);
                    bf16_t* img; int kv;
                    if (smp) { const int rs = row - MP, b = rs >> 4; kv = rs & 15; img = VTS + ((size_t)(b * NH + head) * NTS + (NTS - 1)) * 8192; }
                    else { const int b = row >> 11, t = row & (T - 1); kv = t & 63; img = VTP + ((size_t)(b * NH + head) * (T / 64) + (t >> 6)) * 8192; }
                    st8b(img + wc * 2048 + (kv >> 4) * 512 + (kv & 15) * 32 + 8 * fq, v); } }
        } else if (pn < 16 || (pn >= 20 && pn < 24)) {
            bf16_t* dst = pn < 16 ? GA : GS; const int c0 = (pn < 16 ? pn - 12 : pn - 20) * 256 + 32 * wc + 8 * fq;
            EPI_FOR_ROWS { const int row = EPI_ROW; const float ri = row_rinv(ssq, row);
#pragma unroll
                for (int bj = 0; bj < 2; ++bj) { EPI_GET8(v, bj);
#pragma unroll
                    for (int j = 0; j < 8; ++j) v[j] = siluf_(v[j] * ri);
                    st8b(dst + (size_t)row * D + c0 + 128 * bj, v); } }
        } else if (pn < 20) {
            EPI_FOR_ROWS { const int row = EPI_ROW; const float ri = row_rinv(ssq, row);
#pragma unroll
                for (int bj = 0; bj < 2; ++bj) { EPI_GET8(v, bj);
#pragma unroll
                    for (int j = 0; j < 8; ++j) v[j] *= ri;
                    const int ct = (pn - 16) * 256 + 128 * bj + 32 * wc + 8 * fq;
                    if (smp) st8f(US + (size_t)(row - MP) * D + ct, v);
                    else st8b(UX + ((size_t)(ct >> 4) * NPAIR + (row >> 5)) * KX + (row & 31) * GC + (ct & 15), v); } }
        } else {
            const int c0 = (pn - 24) * 256 + 32 * wc + 8 * fq;
            EPI_FOR_ROWS { const int row = EPI_ROW; const float ri = row_rinv(ssq, row);
#pragma unroll
                for (int bj = 0; bj < 2; ++bj) { EPI_GET8(v, bj);
#pragma unroll
                    for (int j = 0; j < 8; ++j) v[j] = sigmoidf_(v[j] * ri);
                    st8b(GL + (size_t)row * 2048 + c0 + 128 * bj, v); } }
        }
    }
};
struct EpiS1 { float* HF;
    __device__ __forceinline__ void operator()(AccRef acc, const Unit& u, int wr, int wc, int fr, int fq) const {
        EPI_FOR_ROWS { const int row = EPI_ROW; EPI_GET8(v, 0); st8f(HF + ((size_t)u.grp * NPAIR + row) * 128 + 32 * wc + 8 * fq, v); } } };
struct EpiS2 { bf16_t* YS;
    __device__ __forceinline__ void operator()(AccRef acc, const Unit& u, int wr, int wc, int fr, int fq) const {
        EPI_FOR_ROWS { const int pair = EPI_ROW;
#pragma unroll
            for (int bj = 0; bj < 2; ++bj) { EPI_GET8(v, bj);
#pragma unroll
                for (int j = 0; j < 8; ++j) v[j] = geluf_(v[j]);
                const int col = u.pn * 256 + 128 * bj + 32 * wc + 8 * fq, jt = col >> 4, no = col & 15;
                st8b(YS + ((size_t)pair * LC + jt) * D + u.grp * GC + no, v); } } } };
struct EpiAP { const bf16_t* GL; bf16_t* MGA;
    __device__ __forceinline__ void operator()(AccRef acc, const Unit& u, int wr, int wc, int fr, int fq) const {
        EPI_FOR_ROWS { const int row = EPI_ROW;
#pragma unroll
            for (int bj = 0; bj < 2; ++bj) { EPI_GET8(v, bj); const int col = u.pn * 256 + 128 * bj + 32 * wc + 8 * fq; float g[8]; ld8b(GL + (size_t)row * 2048 + col, g);
#pragma unroll
                for (int j = 0; j < 8; ++j) v[j] *= g[j];
                st8b(MGA + (size_t)row * D + col, v); } } } };
struct EpiGLU { const bf16_t* YS; const bf16_t* GS; const float* bias; bf16_t* Z;
    __device__ __forceinline__ void operator()(AccRef acc, const Unit& u, int wr, int wc, int fr, int fq) const {
        float bv[2][8];
#pragma unroll
        for (int bj = 0; bj < 2; ++bj) ld8f(bias + u.pn * 256 + 128 * bj + 32 * wc + 8 * fq, bv[bj]);
        EPI_FOR_ROWS { const int row = EPI_ROW;
#pragma unroll
            for (int bj = 0; bj < 2; ++bj) { EPI_GET8(v, bj); const int col = u.pn * 256 + 128 * bj + 32 * wc + 8 * fq; float y[8], g[8]; ld8b(YS + (size_t)row * D + col, y); ld8b(GS + (size_t)row * D + col, g);
#pragma unroll
                for (int j = 0; j < 8; ++j) v[j] = y[j] * sigmoidf_(v[j] + bv[bj][j]) * g[j];
                st8b(Z + (size_t)row * D + col, v); } } } };
struct EpiSP { const bf16_t* GL; const bf16_t* MGA; bf16_t* MG;
    __device__ __forceinline__ void operator()(AccRef acc, const Unit& u, int wr, int wc, int fr, int fq) const {
        EPI_FOR_ROWS { const int row = EPI_ROW;
#pragma unroll
            for (int bj = 0; bj < 2; ++bj) { EPI_GET8(v, bj); const int col = u.pn * 256 + 128 * bj + 32 * wc + 8 * fq; float g[8], a[8]; ld8b(GL + (size_t)row * 2048 + D + col, g); ld8b(MGA + (size_t)row * D + col, a);
#pragma unroll
                for (int j = 0; j < 8; ++j) v[j] = a[j] + g[j] * v[j];
                st8b(MG + (size_t)row * D + col, v); } } } };
struct EpiOut { const float* xp; const float* xs; float* y; bf16_t* XB; float* ssq; int next;
    __device__ __forceinline__ void operator()(AccRef acc, const Unit& u, int wr, int wc, int fr, int fq) const {
        const bool smp = (u.pm == MP / 256);
        EPI_FOR_ROWS { const int row = EPI_ROW; float s = 0.f;
#pragma unroll
            for (int bj = 0; bj < 2; ++bj) { EPI_GET8(v, bj); const int col = u.pn * 256 + 128 * bj + 32 * wc + 8 * fq; float x[8];
                ld8f((smp ? xs + (size_t)(row - MP) * D : xp + (size_t)row * D) + col, x);
#pragma unroll
                for (int j = 0; j < 8; ++j) { v[j] += x[j]; s += v[j] * v[j]; }
                st8f(y + (size_t)row * D + col, v);
                if (next) st8b(XB + (size_t)row * D + col, v); }
            if (next) { s += __shfl_xor(s, 16); s += __shfl_xor(s, 32); if (fq == 0) ssq[(size_t)row * 16 + u.pn * 4 + wc] = s; } } } };

constexpr int AT_SLOT = 32768, AT_CB = 65536, AT_LS = 131072;
struct AttnJob { const bf16_t* Q; const bf16_t* K; const bf16_t* V; const bf16_t* GA; bf16_t* OA; const float* subg; int kmap; int nt; int qrow0, qpos0, head, sample; float lam, shift2, outscale; };
__device__ __forceinline__ int crow(int r, int hi) { return (r & 3) + 8 * (r >> 2) + 4 * hi; }
__device__ __forceinline__ void attn_unit(LAS unsigned char* lds, const AttnJob& J_) {
    AttnJob J = J_; asm volatile("" : "+s"(J.head), "+s"(J.qpos0), "+s"(J.qrow0), "+s"(J.sample), "+s"(J.nt));
    int tid = threadIdx.x; asm volatile("" : "+v"(tid));
    const int lane = tid & 63, r32 = lane & 31, hi = lane >> 5; const int wid = __builtin_amdgcn_readfirstlane(tid >> 6), mapi = wid >> 2, sub = wid & 3;
    const float slope2 = __builtin_amdgcn_exp2f(-(float)(J.head + 1)) * LOG2E;
    const int tq0 = J.qpos0 + 32 * sub, tq = tq0 + (J.sample ? (r32 & 15) : r32);
    const int mychunk = tq0 >> 6;
    const int ntl = J.sample ? (sub == 0 ? J.nt : 0) : (mychunk + 1);
    const int qrow = J.qrow0 + 32 * sub + (J.sample ? (r32 & 15) : r32);
    const bf16_t* src[4]; unsigned tstr[4];
#pragma unroll
    for (int i = 0; i < 4; ++i) { const int pc = wid * 4 + i;
        if (pc < 16) { src[i] = J.K + (size_t)(pc >> 3) * J.kmap + (pc & 7) * 512 + lane * 8; tstr[i] = 4096; }
        else { src[i] = J.V + (pc - 16) * 512 + lane * 8; tstr[i] = 8192; } }
#define AT_DMA(t, slot) do { _Pragma("unroll") for (int _i = 0; _i < 4; ++_i) \
        __builtin_amdgcn_global_load_lds((const unsigned*)(src[_i] + (size_t)(t) * tstr[_i]), (LAS unsigned*)(lds + (slot) * AT_SLOT + (wid * 4 + _i) * 1024), 16, 0, 0); } while (0)
    AT_DMA(0, 0);
    bf16x8 qr[4];
#pragma unroll
    for (int d0 = 0; d0 < 4; ++d0) qr[d0] = *(const bf16x8*)(J.Q + (size_t)qrow * D + mapi * 512 + J.head * HD + d0 * 16 + hi * 8);
    f32x16 o[4];
#pragma unroll
    for (int e = 0; e < 4; ++e) o[e] = (f32x16){};
    float lsum = 0.f;
    for (int t = 0; t < J.nt; ++t) {
        VM_WAIT(); __syncthreads();
        if (t + 1 < J.nt) AT_DMA(t + 1, (t + 1) & 1);
        if (t < ntl) {
            const LAS unsigned char* Ks = lds + (t & 1) * AT_SLOT + mapi * 8192;
            const LAS unsigned char* Vs = lds + (t & 1) * AT_SLOT + 16384;
            const LAS unsigned char* kb = Ks + hi * 1024 + r32 * 16;
            f32x16 p0, p1;
#pragma unroll
            for (int d0 = 0; d0 < 4; ++d0) {
                const bf16x8 b0 = *(const LAS bf16x8*)(kb + d0 * 2048), b1 = *(const LAS bf16x8*)(kb + d0 * 2048 + 512);
                p0 = __builtin_amdgcn_mfma_f32_32x32x16_bf16(b0, qr[d0], d0 == 0 ? (f32x16){} : p0, 0, 0, 0);
                p1 = __builtin_amdgcn_mfma_f32_32x32x16_bf16(b1, qr[d0], d0 == 0 ? (f32x16){} : p1, 0, 0, 0); }
            if (t < mychunk) {
                const float base = slope2 * (float)(64 * t + 4 * hi - tq) - J.shift2, base1 = base + 32.0f * slope2;
#pragma unroll
                for (int r = 0; r < 16; ++r) { const float kr = slope2 * (float)((r & 3) + 8 * (r >> 2)); p0[r] += kr + base; p1[r] += kr + base1; }
            } else {
#pragma unroll
                for (int r = 0; r < 16; ++r) { const int kr = crow(r, hi); const float d0 = (float)(64 * t + kr - tq);
                    p0[r] += -slope2 * __builtin_fabsf(d0) - J.shift2; p1[r] += -slope2 * __builtin_fabsf(d0 + 32.0f) - J.shift2;
                    if (J.sample) { if (kr >= DS) p0[r] = -1e30f; p1[r] = -1e30f; } }
            }
            float sa = 0.f, sb = 0.f;
#pragma unroll
            for (int r = 0; r < 16; ++r) { p0[r] = __builtin_amdgcn_exp2f(p0[r]); p1[r] = __builtin_amdgcn_exp2f(p1[r]); sa += p0[r]; sb += p1[r]; }
            lsum += sa + sb;
            u32x4 pw[4];
#pragma unroll
            for (int k = 0; k < 4; ++k) { pw[0][k] = pk2bf(p0[2 * k], p0[2 * k + 1]); pw[1][k] = pk2bf(p0[8 + 2 * k], p0[9 + 2 * k]); pw[2][k] = pk2bf(p1[2 * k], p1[2 * k + 1]); pw[3][k] = pk2bf(p1[8 + 2 * k], p1[9 + 2 * k]); }
            const LAS unsigned char* vb = Vs + ((lane >> 4) & 1) * 32 + (lane & 3) * 8 + (4 * hi + ((lane & 15) >> 2)) * 64;
#pragma unroll
            for (int eb = 0; eb < 4; ++eb)
#pragma unroll
                for (int ks = 0; ks < 4; ++ks) {
                    const s16x4 lo = __builtin_bit_cast(s16x4, __builtin_amdgcn_ds_read_tr16_b64_v4i16((LAS s16x4*)(vb + eb * 4096 + ks * 1024)));
                    const s16x4 hh = __builtin_bit_cast(s16x4, __builtin_amdgcn_ds_read_tr16_b64_v4i16((LAS s16x4*)(vb + eb * 4096 + ks * 1024 + 512)));
                    const bf16x8 vf = {lo[0], lo[1], lo[2], lo[3], hh[0], hh[1], hh[2], hh[3]};
                    o[eb] = __builtin_amdgcn_mfma_f32_32x32x16_bf16(__builtin_bit_cast(bf16x8, pw[ks]), vf, o[eb], 0, 0, 0); }
        }
    }
#undef AT_DMA
    lsum += __shfl_xor(lsum, 32);
    LAS float* ls = (LAS float*)(lds + AT_LS) + wid * 32;
    LAS float* cb = (LAS float*)(lds + AT_CB) + sub * 4096;
    const bool act = ntl > 0;
    if (act) {
        if (hi == 0) ls[r32] = lsum;
        LDS_WAIT();
        float f[16];
#pragma unroll
        for (int r = 0; r < 16; ++r) f[r] = (mapi ? J.lam : 1.0f) * __builtin_amdgcn_rcpf(ls[crow(r, hi)]);
#pragma unroll
        for (int eb = 0; eb < 4; ++eb)
#pragma unroll
            for (int r = 0; r < 16; ++r) o[eb][r] *= f[r];
        if (mapi) {
#pragma unroll
            for (int eb = 0; eb < 4; ++eb)
#pragma unroll
                for (int r = 0; r < 16; ++r) cb[(eb * 16 + r) * 64 + lane] = o[eb][r];
        }
    }
    __syncthreads();
    if (act && mapi == 0) {
        float ss[16];
#pragma unroll
        for (int r = 0; r < 16; ++r) ss[r] = 0.f;
#pragma unroll
        for (int eb = 0; eb < 4; ++eb)
#pragma unroll
            for (int r = 0; r < 16; ++r) { o[eb][r] -= cb[(eb * 16 + r) * 64 + lane]; ss[r] += o[eb][r] * o[eb][r]; }
#pragma unroll
        for (int r = 0; r < 16; ++r) { float s = ss[r]; s += __shfl_xor(s, 1); s += __shfl_xor(s, 2); s += __shfl_xor(s, 4); s += __shfl_xor(s, 8); s += __shfl_xor(s, 16);
            ss[r] = __builtin_amdgcn_rsqf(s * (1.0f / VD) + EPS) * J.outscale; }
#pragma unroll
        for (int eb = 0; eb < 4; ++eb) { const int e = eb * 32 + r32; const float sg = J.subg[e];
#pragma unroll
            for (int r = 0; r < 16; ++r) { const int qi = crow(r, hi);
                if (!J.sample || qi < DS) { const size_t idx = (size_t)(J.qrow0 + 32 * sub + qi) * D + J.head * VD + e;
                    J.OA[idx] = f2bf(o[eb][r] * ss[r] * sg * bf2f(J.GA[idx])); } } }
    }
}

#define XB_TMO      128
#define XB_XCNT(j)  (256  + 64 * (j))
#define XB_XSUB(j)  (1280 + 64 * (j))
#define XB_XGEN(j)  (2304 + 64 * (j))
#define XB_TOP      3328
#define XB_TOPGEN   3392
#define XCD_BAR_WORDS 3456
#define XB_SPIN_CAP (1u << 20)
__device__ __forceinline__ unsigned xb_ld(unsigned* p)              { return __hip_atomic_load(p, __ATOMIC_RELAXED, __HIP_MEMORY_SCOPE_AGENT); }
__device__ __forceinline__ unsigned xb_add(unsigned* p, unsigned v) { return __hip_atomic_fetch_add(p, v, __ATOMIC_RELAXED, __HIP_MEMORY_SCOPE_AGENT); }
__device__ __forceinline__ unsigned xb_xcc_id() { return (unsigned)__builtin_amdgcn_s_getreg((3 << 11) | 20) & 0xFu; }
#define XB_SPIN(cond, bar) do { unsigned _sp = 0; while (cond) { __builtin_amdgcn_s_sleep(1); \
    if ((++_sp & 255u) == 0u) { if (xb_ld(&(bar)[XB_TMO])) break; if (_sp > XB_SPIN_CAP) { atomicAdd(&(bar)[XB_TMO], 1u); break; } } } } while (0)
struct XcdBarrier { unsigned* bar; unsigned x; volatile LAS unsigned* st; };
__device__ __forceinline__ XcdBarrier xcd_barrier_post(unsigned* bar, volatile LAS unsigned* st) {
    XcdBarrier b; b.bar = bar; b.x = xb_xcc_id(); b.st = st;
    if (threadIdx.x == 0) (void)xb_add(&bar[XB_XCNT(b.x)], 1u);
    return b;
}
__device__ __forceinline__ void xcd_barrier_complete(unsigned* bar, unsigned x, unsigned& nloc, unsigned& nx) {
    const unsigned G = gridDim.x * gridDim.y * gridDim.z;
    unsigned sum, cnt, mine, sp = 0u;
    for (;;) {
        sum = 0u; cnt = 0u; mine = 0u;
#pragma unroll
        for (unsigned j = 0; j < 16; ++j) { const unsigned c = xb_ld(&bar[XB_XCNT(j)]); sum += c; cnt += (c > 0u) ? 1u : 0u; mine = (j == x) ? c : mine; }
        if (sum == G) break;
        __builtin_amdgcn_s_sleep(1);
        if ((++sp & 255u) == 0u) { if (xb_ld(&bar[XB_TMO])) break; if (sp > XB_SPIN_CAP) { atomicAdd(&bar[XB_TMO], 1u); break; } }
    }
    nloc = mine > 0u ? mine : 1u; nx = cnt > 0u ? cnt : 1u;
}
__device__ __forceinline__ void xcd_barrier(const XcdBarrier& b) {
    asm volatile("s_waitcnt vmcnt(0)" ::: "memory");
    __syncthreads();
    if (threadIdx.x == 0) {
        unsigned* bar = b.bar; unsigned bx_ = b.x; asm volatile("" : "+s"(bar), "+s"(bx_));
        __builtin_amdgcn_s_waitcnt(0);
        unsigned nloc = b.st[0], nx = b.st[1];
        if (nloc == 0u) { xcd_barrier_complete(bar, bx_, nloc, nx); b.st[0] = nloc; b.st[1] = nx; }
        const unsigned old = xb_add(&bar[XB_XSUB(bx_)], 1u);
        const unsigned gen = old / nloc;
        if (old + 1u == (gen + 1u) * nloc) {
            __builtin_amdgcn_fence(__ATOMIC_RELEASE, "agent");
            asm volatile("s_waitcnt vmcnt(0)" ::: "memory");
            const unsigned og = xb_add(&bar[XB_TOP], 1u);
            const unsigned tg = og / nx;
            if (og + 1u == (tg + 1u) * nx) xb_add(&bar[XB_TOPGEN], 1u);
            else XB_SPIN(xb_ld(&bar[XB_TOPGEN]) == tg, bar);
            __builtin_amdgcn_fence(__ATOMIC_ACQUIRE, "agent");
            xb_add(&bar[XB_XGEN(bx_)], 1u);
            asm volatile("s_waitcnt vmcnt(0)" ::: "memory");
        } else {
            XB_SPIN(xb_ld(&bar[XB_XGEN(bx_)]) == gen, bar);
            __builtin_amdgcn_fence(__ATOMIC_ACQUIRE, "agent");
            asm volatile("s_waitcnt vmcnt(0)" ::: "memory");
        }
    }
    __syncthreads();
}

#ifndef PHM
#define PHM 0xFFFF
#endif
#define PH(k) ((PHM >> (k)) & 1)
constexpr int NWAVES = 8, NTHREADS = 512;
constexpr int LDS_BYTES = 147456, MISC_OFF = 131072 + 1024 + 320;
struct Args { const float* in[28]; float* out; unsigned char* ws; };

__device__ __forceinline__ float wave_sum(float v) {
#pragma unroll
    for (int o = 1; o < 64; o <<= 1) v += __shfl_xor(v, o);
    return v;
}
__device__ __forceinline__ void transpose_item(const float* W, int K, int N, bf16_t* WT, LAS float* scr, int item, int lane, const float* kscale, bool headperm) {
    const int nblk = N / 32, kb = item / nblk, nb = item % nblk, k0 = 64 * kb, n0 = 32 * nb;
#pragma unroll 8
    for (int i = 0; i < 32; ++i) { const int kk = 2 * i + (lane >> 5); float v = W[(size_t)(k0 + kk) * N + n0 + (lane & 31)]; if (kscale) v *= kscale[k0 + kk]; scr[kk * 33 + (lane & 31)] = v; }
    LDS_WAIT(); asm volatile("" ::: "memory");
    int rbase = n0; if (headperm && n0 < 2048) { const int l = n0 & 255; rbase = (n0 & ~255) + 128 * ((l >> 5) & 1) + 32 * (l >> 6); }
    const int c = lane & 7;
#pragma unroll
    for (int j = 0; j < 4; ++j) { const int n = (lane >> 3) + 8 * j; const LAS float* s = scr + (8 * c) * 33 + n;
        u32x4 o; o.x = pk2bf(s[0 * 33], s[1 * 33]); o.y = pk2bf(s[2 * 33], s[3 * 33]); o.z = pk2bf(s[4 * 33], s[5 * 33]); o.w = pk2bf(s[6 * 33], s[7 * 33]);
        *(u32x4*)(WT + (size_t)(rbase + n) * K + k0 + 8 * c) = o; }
    LDS_WAIT(); asm volatile("" ::: "memory");
}

__device__ __forceinline__ void ssm_tables(LAS unsigned char* lds, const __attribute__((address_space(4))) Args* Ap, int l, int unit) {
    int tid = threadIdx.x; asm volatile("" : "+v"(tid));
    const int g = unit >> 2, q4 = unit & 3;
    LAS float* AP = (LAS float*)lds;
    LAS float* BB = AP + 33 * 64 * 2;
    LAS float* CT = BB + 64 * 16 * 2;
    LAS float* KC = CT + 16 * 64 * 2;
    const float* lre = Ap->in[16] + (size_t)l * NG * SP; const float* lim = Ap->in[17] + (size_t)l * NG * SP; const float* ldt = Ap->in[18] + (size_t)l * NG;
    const float* bre = Ap->in[19] + (size_t)l * NG * SP * GC; const float* bim = Ap->in[20] + (size_t)l * NG * SP * GC;
    const float* cre = Ap->in[21] + (size_t)l * NG * GC * SP; const float* cim = Ap->in[22] + (size_t)l * NG * GC * SP; const float* dsk = Ap->in[23] + (size_t)l * D;
    __syncthreads();
    if (tid < 64) { const int p = tid; const float lr = lre[g * SP + p], li = lim[g * SP + p], dt = __expf(ldt[g]);
        for (int tau = 0; tau <= 32; ++tau) { const float mg = __expf(lr * dt * (float)tau); float tr = li * dt * (float)tau * 0.15915494309189535f; tr -= rintf(tr);
            AP[(tau * 64 + p) * 2] = mg * __builtin_amdgcn_cosf(tr); AP[(tau * 64 + p) * 2 + 1] = mg * __builtin_amdgcn_sinf(tr); }
        const float ar = AP[(64 + p) * 2], ai = AP[(64 + p) * 2 + 1], zr = ar - 1.0f, zi = ai, den = lr * lr + li * li;
        const float wre = (zr * lr + zi * li) / den, wim = (zi * lr - zr * li) / den;
        for (int n = 0; n < GC; ++n) { const float br = bre[(g * SP + p) * GC + n], bi = bim[(g * SP + p) * GC + n]; BB[(p * GC + n) * 2] = wre * br - wim * bi; BB[(p * GC + n) * 2 + 1] = wre * bi + wim * br; }
        if (q4 == 0) { float* a32 = (float*)(Ap->ws + WS_SCAL) + SC_A32 + ((size_t)(l * NG + g) * SP + p) * 2; a32[0] = AP[(32 * 64 + p) * 2]; a32[1] = AP[(32 * 64 + p) * 2 + 1]; }
    }
    for (int i = tid; i < GC * SP; i += NTHREADS) { CT[i * 2] = cre[(size_t)g * GC * SP + i]; CT[i * 2 + 1] = cim[(size_t)g * GC * SP + i]; }
    __syncthreads();
    {
        const int tau = tid >> 4, no = tid & 15; float a[GC];
#pragma unroll
        for (int n = 0; n < GC; ++n) a[n] = 0.f;
        for (int p = 0; p < SP; ++p) { const float cr = CT[(no * SP + p) * 2], ci = CT[(no * SP + p) * 2 + 1], pr = AP[(tau * 64 + p) * 2], pi = AP[(tau * 64 + p) * 2 + 1];
            const float xr = cr * pr - ci * pi, xi = cr * pi + ci * pr;
#pragma unroll
            for (int n = 0; n < GC; ++n) a[n] += xr * BB[(p * GC + n) * 2] - xi * BB[(p * GC + n) * 2 + 1]; }
        if (tau == 0) { const float dv = dsk[g * GC + no];
#pragma unroll
            for (int n = 0; n < GC; ++n) if (n == no) a[n] += dv; }
#pragma unroll
        for (int n = 0; n < GC; ++n) KC[(tau * GC + no) * GC + n] = a[n];
    }
    __syncthreads();
    bf16_t* BT2 = (bf16_t*)(Ap->ws + WS_BT2) + (size_t)g * (LC * GC) * KX; bf16_t* BT1 = (bf16_t*)(Ap->ws + WS_BT1) + (size_t)g * 128 * (LC * GC);
    for (int ch = tid; ch < 128 * (KX / 8); ch += NTHREADS) {
        const int rl = ch / (KX / 8), k8 = ch % (KX / 8), row = q4 * 128 + rl, j = row >> 4, no = row & 15, k = k8 * 8; float v[8];
        if (k < LC * GC) { const int s = k >> 4, ni0 = k & 15, tau = j - s;
#pragma unroll
            for (int i = 0; i < 8; ++i) v[i] = tau >= 0 ? KC[(tau * GC + no) * GC + ni0 + i] : 0.f;
        } else { const int pi0 = k - LC * GC, part = pi0 >> 6, p0 = pi0 & 63;
#pragma unroll
            for (int i = 0; i < 8; ++i) { const int p = p0 + i; const float cr = CT[(no * SP + p) * 2], ci = CT[(no * SP + p) * 2 + 1], pr = AP[((j + 1) * 64 + p) * 2], pim = AP[((j + 1) * 64 + p) * 2 + 1];
                v[i] = part == 0 ? (cr * pr - ci * pim) : -(cr * pim + ci * pr); } }
        st8b(BT2 + (size_t)row * KX + k, v);
    }
    for (int ch = tid; ch < 32 * 64; ch += NTHREADS) {
        const int rl = ch >> 6, k8 = ch & 63, row = q4 * 32 + rl, part = row >> 6, p = row & 63, k = k8 * 8, s = k >> 4, ni0 = k & 15; float v[8];
        const float pr = AP[((31 - s) * 64 + p) * 2], pim = AP[((31 - s) * 64 + p) * 2 + 1];
#pragma unroll
        for (int i = 0; i < 8; ++i) { const float br = BB[(p * GC + ni0 + i) * 2], bi = BB[(p * GC + ni0 + i) * 2 + 1]; v[i] = part == 0 ? (pr * br - pim * bi) : (pr * bi + pim * br); }
        st8b(BT1 + (size_t)row * (LC * GC) + k, v);
    }
    __syncthreads();
}

typedef const __attribute__((address_space(4))) Args* ArgsP;
__device__ __forceinline__ ArgsP fresh_args() { ArgsP p = (ArgsP)__builtin_amdgcn_kernarg_segment_ptr(); asm volatile("" : "+s"(p)); return p; }
#define WSP(T, off) ((T*)(ws + (off)))
__global__ void __launch_bounds__(NTHREADS, 2) mega_fwd(Args A_unused) {
    extern __shared__ __attribute__((aligned(16))) unsigned char lds_raw[];
    LAS unsigned char* lds = (LAS unsigned char*)lds_raw;
    volatile LAS unsigned* MISC = (volatile LAS unsigned*)(lds + MISC_OFF);
    const int G = gridDim.x, bx = blockIdx.x; const int vcu = (G % 8 == 0) ? (bx % 8) * (G / 8) + bx / 8 : bx;
    for (int u = threadIdx.x; u < 32; u += NTHREADS) MISC[u] = 0u;
    __syncthreads();
    XcdBarrier bar = xcd_barrier_post((unsigned*)(fresh_args()->ws + WS_CTL) + 4096, MISC + 8);
#define PHASE_BEGIN const ArgsP A = fresh_args(); unsigned char* const ws = A->ws; int tid = threadIdx.x; asm volatile("" : "+v"(tid)); \
    const int lane = tid & 63, wave = __builtin_amdgcn_readfirstlane(tid >> 6), gw = vcu * NWAVES + wave, NGW = G * NWAVES; (void)lane; (void)gw; (void)NGW; (void)ws;

#if PH(0)
    {
        PHASE_BEGIN
        bf16_t* XB = WSP(bf16_t, WS_XB); float* SSQ = WSP(float, WS_SSQ); float* scal = WSP(float, WS_SCAL); bf16_t* KTS = WSP(bf16_t, WS_KTS); bf16_t* VTS = WSP(bf16_t, WS_VTS);
        LAS float* scr = (LAS float*)(lds + wave * 16384);
        constexpr int I_IN = (D / 64) * (INC / 32), I_SM = (D / 64) * (D / 32), I_L = I_IN + 4 * I_SM;
        for (int it = gw; it < DEPTH * I_L; it += NGW) {
            const int l = it / I_L; int r = it % I_L;
            if (r < I_IN) { transpose_item(A->in[7] + (size_t)l * D * INC, D, INC, WSP(bf16_t, WS_WIN) + (size_t)l * INC * D, scr, r, lane, A->in[6] + l * D, true); continue; }
            r -= I_IN; const int w = r / I_SM; r %= I_SM;
            const float* src = (w == 0 ? A->in[15] : w == 1 ? A->in[24] : w == 2 ? A->in[26] : A->in[27]) + (size_t)l * D * D;
            transpose_item(src, D, D, WSP(bf16_t, WS_WSM) + (size_t)(l * 4 + w) * D * D, scr, r, lane, nullptr, false);
        }
        for (int m = gw; m < MT; m += NGW) {
            const float* xr = (m < MP ? A->in[0] + (size_t)m * D : A->in[1] + (size_t)(m - MP) * D); float s = 0.f;
#pragma unroll
            for (int j = 0; j < 4; ++j) { const f32x4 v = *(const f32x4*)(xr + j * 256 + lane * 4); s += (v[0] * v[0] + v[1] * v[1]) + (v[2] * v[2] + v[3] * v[3]);
                u32x2 w; w.x = pk2bf(v[0], v[1]); w.y = pk2bf(v[2], v[3]); *(u32x2*)(XB + (size_t)m * D + j * 256 + lane * 4) = w; }
            s = wave_sum(s);
            if (lane < 16) SSQ[(size_t)m * 16 + lane] = lane == 0 ? s : 0.f;
        }
        if (bx == 0 && wave < DEPTH) {
            const int l = wave; const float a = A->in[10][l * HD + lane] * A->in[11][l * HD + lane], b = A->in[12][l * HD + lane] * A->in[13][l * HD + lane];
            const float s1 = wave_sum(a), s2 = wave_sum(b);
            float mq = __builtin_fabsf(A->in[8][l * HD + lane]), mk = __builtin_fabsf(A->in[9][l * HD + lane]);
#pragma unroll
            for (int o = 1; o < 64; o <<= 1) { mq = __builtin_fmaxf(mq, __shfl_xor(mq, o)); mk = __builtin_fmaxf(mk, __shfl_xor(mk, o)); }
            const float lam_init = 0.8f - 0.6f * __expf(-0.3f * (float)l);
            if (lane == 0) { scal[l * 8 + 0] = __expf(s1) - __expf(s2) + lam_init; scal[l * 8 + 1] = 8.0f * mq * mk * LOG2E; scal[l * 8 + 2] = 1.0f - lam_init; }
        }
        for (int i = gw * 64 + lane; i < DB * NH * 2 * (4096 / 8); i += NGW * 64) { const int img = i / 512, ch = i % 512; *(u32x4*)(KTS + ((size_t)img * NTS + NTS - 1) * 4096 + ch * 8) = (u32x4){0u, 0u, 0u, 0u}; }
        for (int i = gw * 64 + lane; i < DB * NH * (8192 / 8); i += NGW * 64) { const int img = i / 1024, ch = i % 1024; *(u32x4*)(VTS + ((size_t)img * NTS + NTS - 1) * 8192 + ch * 8) = (u32x4){0u, 0u, 0u, 0u}; }
    }
#endif
    xcd_barrier(bar);

#pragma unroll 1
    for (int l = 0; l < DEPTH; ++l) {
#if PH(9)
        {
            PHASE_BEGIN
            for (int un = vcu; un < NG * 4; un += G) ssm_tables(lds, A, l, un);
            const float* ck = A->in[2] + (size_t)l * DB * PAST * D; const float* cv = A->in[3] + (size_t)l * DB * PAST * D;
            bf16_t* KTS = WSP(bf16_t, WS_KTS); bf16_t* VTS = WSP(bf16_t, WS_VTS);
            const int NI = DB * PAST * (D / 8);
            for (int i = bx * NTHREADS + tid; i < NI; i += G * NTHREADS) {
                const int c8 = i & 127, t = (i >> 7) & (PAST - 1), b = i >> 17, col = c8 * 8; float v[8];
                ld8f(ck + ((size_t)b * PAST + t) * D + col, v);
                { const int mapi = col >> 9, head = (col >> 6) & 7, d8 = (col & 63) >> 3;
                  st8b(KTS + ((size_t)((b * NH + head) * 2 + mapi) * NTS + (t >> 6)) * 4096 + (d8 >> 1) * 1024 + (d8 & 1) * 512 + (t & 63) * 8, v); }
                ld8f(cv + ((size_t)b * PAST + t) * D + col, v);
                { const int head = col >> 7, e = col & 127, kv = t & 63;
                  st8b(VTS + ((size_t)(b * NH + head) * NTS + (t >> 6)) * 8192 + (e >> 5) * 2048 + (kv >> 4) * 512 + (kv & 15) * 32 + (e & 31), v); }
            }
        }
#endif
#if PH(1)
        {
            PHASE_BEGIN
            float* out = A->out;
            pg8::Gemm g{WSP(bf16_t, WS_XB), WSP(bf16_t, WS_WIN) + (size_t)l * INC * D, D, D, D, 0, 0}; pg8::TileOrder S; S.init(MT / 256, INC / 256, 1, G, bx);
            EpiIn E{WSP(float, WS_SSQ), A->in[8] + l * HD, A->in[9] + l * HD, out + O_KP + (size_t)l * MP * D, out + O_VP + (size_t)l * MP * D, out + O_KS + (size_t)l * MS * D, out + O_VS + (size_t)l * MS * D,
                    WSP(bf16_t, WS_QB), WSP(bf16_t, WS_KTP), WSP(bf16_t, WS_VTP), WSP(bf16_t, WS_KTS), WSP(bf16_t, WS_VTS), WSP(bf16_t, WS_GA), WSP(bf16_t, WS_UX), WSP(bf16_t, WS_GS), WSP(bf16_t, WS_GL), WSP(float, WS_US)};
            pg8::gemm_phase(lds, g, S, E);
        }
#endif
        xcd_barrier(bar);

#if PH(2)
        {
            PHASE_BEGIN
            const float* scal = WSP(float, WS_SCAL);
            AttnJob J; J.GA = WSP(bf16_t, WS_GA); J.OA = WSP(bf16_t, WS_XB); J.subg = A->in[14] + l * VD; J.lam = scal[l * 8 + 0]; J.shift2 = scal[l * 8 + 1]; J.outscale = scal[l * 8 + 2]; J.Q = WSP(bf16_t, WS_QB);
#if PH(10)
            for (int it = vcu; it < 512; it += G) {
                const int bh = it >> 3, s = it & 7, b = bh >> 3, h = bh & 7;
                J.K = WSP(bf16_t, WS_KTP) + (size_t)(bh * 2) * (T / 64) * 4096; J.kmap = (T / 64) * 4096; J.V = WSP(bf16_t, WS_VTP) + (size_t)bh * (T / 64) * 8192; J.head = h; J.sample = 0;
#pragma unroll 1
                for (int k = 0; k < 2; ++k) { const int qb = k ? 15 - s : s; J.qrow0 = b * T + qb * 128; J.qpos0 = qb * 128; J.nt = 2 * qb + 2; attn_unit(lds, J); }
            }
#endif
#if PH(11)
            if (bx < DB * NH) {
                const int bh = bx, b = bh >> 3, h = bh & 7;
                J.K = WSP(bf16_t, WS_KTS) + (size_t)(bh * 2) * NTS * 4096; J.kmap = NTS * 4096; J.V = WSP(bf16_t, WS_VTS) + (size_t)bh * NTS * 8192; J.head = h; J.sample = 1;
                J.qrow0 = MP + b * DS; J.qpos0 = PAST; J.nt = NTS; attn_unit(lds, J);
            }
#endif
            __syncthreads();
        }
#if PH(12)
        {
            PHASE_BEGIN
            pg8::Gemm g{WSP(bf16_t, WS_UX), WSP(bf16_t, WS_BT1), KX, LC * GC, LC * GC, (size_t)NPAIR * KX, (size_t)128 * LC * GC}; pg8::TileOrder S; S.init(2, 1, NG, 128, bx >= 128 ? bx - 128 : -1);
            EpiS1 E{WSP(float, WS_HF)};
            pg8::gemm_phase(lds, g, S, E);
        }
#endif
#endif
        xcd_barrier(bar);

#if PH(3)
        {
            PHASE_BEGIN
            float* out = A->out; float* HF = WSP(float, WS_HF); bf16_t* UX = WSP(bf16_t, WS_UX); bf16_t* YS = WSP(bf16_t, WS_QB); const float* US = WSP(float, WS_US);
            const float* a32t = WSP(float, WS_SCAL) + SC_A32 + (size_t)l * NG * SP * 2;
            for (int it = gw; it < NB * NG; it += NGW) {
                const int b = it >> 6, g = it & 63, p = lane; const float ar = a32t[(g * SP + p) * 2], ai = a32t[(g * SP + p) * 2 + 1];
                const float* hf = HF + ((size_t)g * NPAIR + b * 64) * 128; bf16_t* ux = UX + ((size_t)g * NPAIR + b * 64) * KX + LC * GC;
                float hr = 0.f, hi_ = 0.f;
#pragma unroll 1
                for (int c0 = 0; c0 < 64; c0 += 16) { float fr_[16], fi_[16];
#pragma unroll
                    for (int c = 0; c < 16; ++c) { fr_[c] = hf[(size_t)(c0 + c) * 128 + p]; fi_[c] = hf[(size_t)(c0 + c) * 128 + 64 + p]; }
#pragma unroll
                    for (int c = 0; c < 16; ++c) { ux[(size_t)(c0 + c) * KX + p] = f2bf(hr); ux[(size_t)(c0 + c) * KX + 64 + p] = f2bf(hi_);
                        const float nr = ar * hr - ai * hi_ + fr_[c], ni = ar * hi_ + ai * hr + fi_[c]; hr = nr; hi_ = ni; } }
                out[O_HRP + ((size_t)(l * NB + b) * NG + g) * SP + p] = hr; out[O_HIP + ((size_t)(l * NB + b) * NG + g) * SP + p] = hi_;
            }
            LAS float* hs = (LAS float*)(lds + wave * 8192);
            for (int it = gw; it < DB * NG; it += NGW) {
                const int b = it >> 6, g = it & 63, p = lane;
                const float lr = A->in[16][(size_t)(l * NG + g) * SP + p], li = A->in[17][(size_t)(l * NG + g) * SP + p], dt = __expf(A->in[18][l * NG + g]);
                const float mg = __expf(lr * dt); float tr = li * dt * 0.15915494309189535f; tr -= rintf(tr);
                const float ar = mg * __builtin_amdgcn_cosf(tr), ai = mg * __builtin_amdgcn_sinf(tr), zr = ar - 1.0f, zi = ai, den = lr * lr + li * li;
                const float wre = (zr * lr + zi * li) / den, wim = (zi * lr - zr * li) / den;
                float bbr[GC], bbi[GC];
#pragma unroll
                for (int n = 0; n < GC; ++n) { const float br = A->in[19][((size_t)(l * NG + g) * SP + p) * GC + n], bi = A->in[20][((size_t)(l * NG + g) * SP + p) * GC + n]; bbr[n] = wre * br - wim * bi; bbi[n] = wre * bi + wim * br; }
                float hr = A->in[4][((size_t)(l * DB + b) * NG + g) * SP + p], hi_ = A->in[5][((size_t)(l * DB + b) * NG + g) * SP + p];
                const float* ub = US + (size_t)(b * DS) * D + g * GC;
#pragma unroll 1
                for (int t = 0; t < DS; ++t) { float bur = 0.f, bui = 0.f;
#pragma unroll
                    for (int n = 0; n < GC; ++n) { const float uv = ub[(size_t)t * D + n]; bur += uv * bbr[n]; bui += uv * bbi[n]; }
                    const float nr = ar * hr - ai * hi_ + bur, ni = ar * hi_ + ai * hr + bui; hr = nr; hi_ = ni;
                    hs[(t * 64 + p) * 2] = hr; hs[(t * 64 + p) * 2 + 1] = hi_; }
                out[O_HRS + ((size_t)(l * DB + b) * NG + g) * SP + p] = hr; out[O_HIS + ((size_t)(l * DB + b) * NG + g) * SP + p] = hi_;
                LDS_WAIT(); asm volatile("" ::: "memory");
                const int t = lane >> 2, n4 = (lane & 3) * 4; float y[4] = {0.f, 0.f, 0.f, 0.f};
                const float* cr = A->in[21] + ((size_t)(l * NG + g) * GC + n4) * SP; const float* ci = A->in[22] + ((size_t)(l * NG + g) * GC + n4) * SP;
                for (int q = 0; q < SP; ++q) { const float xr = hs[(t * 64 + q) * 2], xi = hs[(t * 64 + q) * 2 + 1];
#pragma unroll
                    for (int k = 0; k < 4; ++k) y[k] += xr * cr[k * SP + q] - xi * ci[k * SP + q]; }
                u32x2 w; float yv[4];
#pragma unroll
                for (int k = 0; k < 4; ++k) yv[k] = geluf_(y[k] + A->in[23][l * D + g * GC + n4 + k] * ub[(size_t)t * D + n4 + k]);
                w.x = pk2bf(yv[0], yv[1]); w.y = pk2bf(yv[2], yv[3]);
                *(u32x2*)(YS + (size_t)(MP + b * DS + t) * D + g * GC + n4) = w;
                LDS_WAIT(); asm volatile("" ::: "memory");
            }
        }
#endif
        xcd_barrier(bar);

#if PH(4)
#if PH(13)
        { PHASE_BEGIN
          pg8::Gemm g{WSP(bf16_t, WS_UX), WSP(bf16_t, WS_BT2), KX, KX, KX, (size_t)NPAIR * KX, (size_t)(LC * GC) * KX}; pg8::TileOrder S; S.init(2, 2, NG, G, bx);
          EpiS2 E{WSP(bf16_t, WS_QB)}; pg8::gemm_phase(lds, g, S, E); }
#endif
        __syncthreads();
#if PH(14)
        { PHASE_BEGIN
          pg8::Gemm g{WSP(bf16_t, WS_XB), WSP(bf16_t, WS_WSM) + (size_t)(l * 4 + 0) * D * D, D, D, D, 0, 0}; pg8::TileOrder S; S.init(MT / 256, D / 256, 1, G, bx);
          EpiAP E{WSP(bf16_t, WS_GL), WSP(bf16_t, WS_VTP)}; pg8::gemm_phase(lds, g, S, E); }
#endif
#endif
        xcd_barrier(bar);
#if PH(5)
        { PHASE_BEGIN
          pg8::Gemm g{WSP(bf16_t, WS_QB), WSP(bf16_t, WS_WSM) + (size_t)(l * 4 + 1) * D * D, D, D, D, 0, 0}; pg8::TileOrder S; S.init(MT / 256, D / 256, 1, G, bx);
          EpiGLU E{WSP(bf16_t, WS_QB), WSP(bf16_t, WS_GS), A->in[25] + l * D, WSP(bf16_t, WS_GA)}; pg8::gemm_phase(lds, g, S, E); }
#endif
        xcd_barrier(bar);
#if PH(6)
        { PHASE_BEGIN
          pg8::Gemm g{WSP(bf16_t, WS_GA), WSP(bf16_t, WS_WSM) + (size_t)(l * 4 + 2) * D * D, D, D, D, 0, 0}; pg8::TileOrder S; S.init(MT / 256, D / 256, 1, G, bx);
          EpiSP E{WSP(bf16_t, WS_GL), WSP(bf16_t, WS_VTP), WSP(bf16_t, WS_QB)}; pg8::gemm_phase(lds, g, S, E); }
#endif
        xcd_barrier(bar);
#if PH(7)
        { PHASE_BEGIN
          float* out = A->out;
          pg8::Gemm g{WSP(bf16_t, WS_QB), WSP(bf16_t, WS_WSM) + (size_t)(l * 4 + 3) * D * D, D, D, D, 0, 0}; pg8::TileOrder S; S.init(MT / 256, D / 256, 1, G, bx);
          EpiOut E{l == 0 ? A->in[0] : out + O_Y, l == 0 ? A->in[1] : out + O_Y + (size_t)MP * D, out + O_Y, WSP(bf16_t, WS_XB), WSP(float, WS_SSQ), l + 1 < DEPTH ? 1 : 0}; pg8::gemm_phase(lds, g, S, E); }
#endif
        if (l + 1 < DEPTH) xcd_barrier(bar);
    }
}

extern "C" void kernel_launch(void* const* d_in, const int* in_sizes, int n_in, void* d_out, int out_size, void* d_ws, size_t ws_size, hipStream_t stream) {
    static int grid = 0;
    if (grid == 0) {
        if (n_in != 28 || out_size != (int)O_END || ws_size < WS_END) { fprintf(stderr, "kernel_launch: unexpected problem (n_in %d, out %d, ws %zu)\n", n_in, out_size, ws_size); grid = -1; return; }
        int dev = 0, cus = 0, per_cu = 0;
        if (hipGetDevice(&dev) != hipSuccess || hipDeviceGetAttribute(&cus, hipDeviceAttributeMultiprocessorCount, dev) != hipSuccess) { grid = -1; return; }
        if (hipFuncSetAttribute((const void*)mega_fwd, hipFuncAttributeMaxDynamicSharedMemorySize, LDS_BYTES) != hipSuccess) { fprintf(stderr, "kernel_launch: hipFuncSetAttribute failed\n"); grid = -1; return; }
        if (hipOccupancyMaxActiveBlocksPerMultiprocessor(&per_cu, (const void*)mega_fwd, NTHREADS, LDS_BYTES) != hipSuccess || per_cu < 1) { fprintf(stderr, "kernel_launch: occupancy query reports %d\n", per_cu); }
        (void)hipGetLastError();
        grid = cus;
    }
    if (grid < 0) return;
    (void)hipMemsetAsync((char*)d_ws + WS_CTL, 0, CTL_ZERO_BYTES, stream);
    Args a{};
    for (int i = 0; i < 28; ++i) a.in[i] = (const float*)d_in[i];
    a.out = (float*)d_out; a.ws = (unsigned char*)d_ws;
    hipLaunchKernelGGL(mega_fwd, dim3(grid), dim3(NTHREADS), LDS_BYTES, stream, a);
}
```

```cpp
#include <hip/hip_runtime.h>
#include <cstdio>
#include <cstdint>

#define LAS __attribute__((address_space(3)))
#define GAS __attribute__((address_space(1)))
typedef unsigned short bf16_t;
typedef short bf16x8 __attribute__((ext_vector_type(8)));
typedef short s16x4 __attribute__((ext_vector_type(4)));
typedef float f32x2 __attribute__((ext_vector_type(2)));
typedef float f32x4 __attribute__((ext_vector_type(4)));
typedef float f32x16 __attribute__((ext_vector_type(16)));
typedef unsigned u32x2 __attribute__((ext_vector_type(2)));
typedef unsigned u32x4 __attribute__((ext_vector_type(4)));

constexpr int D = 1024, NB = 8, T = 2048, DEPTH = 2, DB = 16, DS = 16, PAST = 1024, NH = 8, HD = 64, VD = 128;
constexpr int MP = NB * T, MS = DB * DS, MT = MP + MS, INC = 8192;
constexpr int NG = 64, GC = 16, SP = 64, LC = 32, NPAIR = MP / LC;
constexpr int KX = LC * GC + 2 * SP;
constexpr float EPS = 1e-6f, LOG2E = 1.4426950408889634f;
constexpr int NTS = PAST / 64 + 1;
constexpr size_t O_Y = 0, O_KP = 17039360, O_VP = 50593792, O_HRP = 84148224, O_HIP = 84213760, O_KS = 84279296, O_VS = 84803584, O_HRS = 85327872, O_HIS = 85458944, O_END = 85590016;
constexpr size_t MiB = 1u << 20;
constexpr size_t WS_CTL = 0, CTL_ZERO_BYTES = 64 * 1024, WS_SCAL = 1 * MiB, WS_WIN = 2 * MiB, WS_WSM = 34 * MiB, WS_BT2 = 50 * MiB, WS_BT1 = 90 * MiB  ,
                 WS_XB = 108 * MiB, WS_QB = 141 * MiB  , WS_KTP = 174 * MiB  , WS_VTP = 207 * MiB  , WS_KTS = 240 * MiB, WS_VTS = 274 * MiB,
                 WS_GA = 308 * MiB  , WS_GS = 341 * MiB, WS_GL = 374 * MiB, WS_UX = 439 * MiB, WS_HF = 479 * MiB, WS_SSQ = 495 * MiB, WS_US = 497 * MiB, WS_KCG = 498 * MiB, WS_END = 502 * MiB;
constexpr size_t WS_OA = WS_QB, WS_MG = WS_QB, WS_YS = WS_KTP, WS_MGA = WS_VTP, WS_Z = WS_GA;
constexpr int SC_A32 = 1024;

__device__ __forceinline__ unsigned pk2bf(float lo, float hi) { typedef __bf16 b2 __attribute__((ext_vector_type(2))); f32x2 v = {lo, hi}; b2 b = __builtin_convertvector(v, b2); return __builtin_bit_cast(unsigned, b); }
__device__ __forceinline__ u32x4 pk8bf(const float* v) { u32x4 w; w.x = pk2bf(v[0], v[1]); w.y = pk2bf(v[2], v[3]); w.z = pk2bf(v[4], v[5]); w.w = pk2bf(v[6], v[7]); return w; }
__device__ __forceinline__ void unpk8bf(u32x4 w, float* v) {
    v[0] = __uint_as_float(w.x << 16); v[1] = __uint_as_float(w.x & 0xffff0000u); v[2] = __uint_as_float(w.y << 16); v[3] = __uint_as_float(w.y & 0xffff0000u);
    v[4] = __uint_as_float(w.z << 16); v[5] = __uint_as_float(w.z & 0xffff0000u); v[6] = __uint_as_float(w.w << 16); v[7] = __uint_as_float(w.w & 0xffff0000u); }
__device__ __forceinline__ float bf2f(bf16_t x) { return __uint_as_float((unsigned)x << 16); }
__device__ __forceinline__ bf16_t f2bf(float f) { return (bf16_t)(pk2bf(f, 0.f) & 0xffffu); }
__device__ __forceinline__ float sigmoidf_(float x) { return __builtin_amdgcn_rcpf(1.0f + __builtin_amdgcn_exp2f(-LOG2E * x)); }
__device__ __forceinline__ float siluf_(float x) { return x * sigmoidf_(x); }
__device__ __forceinline__ float geluf_(float x) { return x * sigmoidf_(1.5957691216057308f * (x + 0.044715f * x * x * x)); }
__device__ __forceinline__ int lane_id() { int l; asm volatile("v_mbcnt_lo_u32_b32 %0, -1, 0\n\tv_mbcnt_hi_u32_b32 %0, -1, %0" : "=v"(l)); return l; }
#define LDS_WAIT() asm volatile("s_waitcnt lgkmcnt(0)" ::: "memory")
#define VM_WAIT() asm volatile("s_waitcnt vmcnt(0)" ::: "memory")

namespace pg8 {
constexpr int BM = 256, BK = 64, HALF = 128, HTB = HALF * BK * 2, STAGE_BYTES = 8 * HTB, NXCD = 8, WGM = 8;
__device__ __forceinline__ int lds_byte(int r, int c) { const int st = (r >> 4) * 2 + (c >> 5), rr = r & 15, cc = c & 31, ob = rr * 64 + cc * 2; return st * 1024 + (ob ^ (((ob >> 9) & 1) << 5)); }
__device__ __forceinline__ void stage_rc(int b, int& R, int& C) { const int st = b / 1024, sb = b % 1024, swz = sb ^ (((sb >> 9) & 1) << 5); R = (st >> 1) * 16 + swz / 64; C = (st & 1) * 32 + (swz % 64) / 2; }
__device__ __forceinline__ int perm32(int rho) { const int n = rho >> 4, i = rho & 15; return 8 * (i >> 2) + 4 * n + (i & 3); }

struct Unit { int pm, pn, grp; };
struct Gemm { const bf16_t* A; const bf16_t* Bt; int lda, ldb, K; size_t gsA, gsB; };

struct TileOrder {
    int nM, nN, per, total, G, c;
    __device__ void init(int nM_, int nN_, int nG_, int G_, int c_) { nM = nM_; nN = nN_; per = nM_ * nN_; total = per * nG_; G = G_; c = c_; }
    __device__ bool next(int i, Unit& u) const {
        if (c < 0) return false;
        const long L = (long)i * G + c; if (L >= total) return false;
        int wgid = (int)L; { const int q = total / NXCD, r = total % NXCD, xcd = wgid % NXCD, off = wgid / NXCD; wgid = (xcd < r ? xcd * (q + 1) : r * (q + 1) + (xcd - r) * q) + off; }
        u.grp = wgid / per; const int rem = wgid % per;
        const int nig = WGM * nN, gid = rem / nig, fm = gid * WGM, gsz = (nM - fm) < WGM ? (nM - fm) : WGM;
        u.pm = fm + ((rem % nig) % gsz); u.pn = (rem % nig) / gsz; return true;
    }
};

template <class Epi>
__device__ __forceinline__ void gemm_phase(LAS unsigned char* lds, const Gemm g, const TileOrder& S, const Epi& E, int tid) {
    const int wid = __builtin_amdgcn_readfirstlane(tid >> 6), lane = tid & 63, wr = wid >> 2, wc = wid & 3, fr = lane & 15, fq = lane >> 4;
    const int nt = g.K / BK;
    unsigned voffA[2], voffB[2];
#pragma unroll
    for (int i = 0; i < 2; ++i) { int R, C; stage_rc(tid * 16 + i * 8192, R, C); const int Rb = (R & ~31) + perm32(R & 31);
        voffA[i] = (unsigned)(R * g.lda + C) * 2u; voffB[i] = (unsigned)(Rb * g.ldb + C) * 2u; }
    const size_t kstep = (size_t)(BK * 2);
    const size_t hstepA = (size_t)HALF * g.lda * 2, hstepB = (size_t)HALF * g.ldb * 2;
    const unsigned ldsw = (unsigned)wid * 1024u;
    const int aoff = lds_byte(wr * 64 + fr, fq * 8), boff = lds_byte(wc * 32 + fr, fq * 8);
#define PG8_SA(b, h) (((b) * 2 + (h)) * HTB)
#define PG8_SB(b, h) ((4 + (b) * 2 + (h)) * HTB)
#define PG8_STAGE(bufoff, gbase, voff) do { _Pragma("unroll") for (int _i = 0; _i < 2; ++_i) \
        __builtin_amdgcn_global_load_lds((const unsigned*)((const char*)(gbase) + (voff)[_i]), (LAS unsigned*)(lds + (bufoff) + ldsw + _i * 8192), 16, 0, 0); } while (0)
#define PG8_LDA(dst, b, h) do { _Pragma("unroll") for (int m = 0; m < 4; ++m) _Pragma("unroll") for (int k = 0; k < 2; ++k) dst[m][k] = *(const LAS bf16x8*)(lds + PG8_SA(b, h) + aoff + m * 2048 + k * 1024); } while (0)
#define PG8_LDB(dst, b, h) do { _Pragma("unroll") for (int n = 0; n < 2; ++n) _Pragma("unroll") for (int k = 0; k < 2; ++k) dst[n][k] = *(const LAS bf16x8*)(lds + PG8_SB(b, h) + boff + n * 2048 + k * 1024); } while (0)
#define PG8_MMA(ai, bj, At, Bt) do { __builtin_amdgcn_s_setprio(1); _Pragma("unroll") for (int m = 0; m < 4; ++m) _Pragma("unroll") for (int n = 0; n < 2; ++n) _Pragma("unroll") for (int k = 0; k < 2; ++k) \
        acc[ai][bj][m][n] = __builtin_amdgcn_mfma_f32_16x16x32_bf16(Bt[n][k], At[m][k], acc[ai][bj][m][n], 0, 0, 0); __builtin_amdgcn_s_setprio(0); } while (0)
#define PG8_WAIT_V(n) asm volatile("s_waitcnt vmcnt(" #n ")" ::: "memory")
#define PG8_WAIT_L(n) asm volatile("s_waitcnt lgkmcnt(" #n ")" ::: "memory")
#define PG8_BAR __builtin_amdgcn_s_barrier()
#define PG8_SCHED __builtin_amdgcn_sched_barrier(0)
#define PG8_ABASE(u) ((const char*)g.A + ((size_t)(u).grp * g.gsA + (size_t)(u).pm * BM * g.lda) * 2)
#define PG8_BBASE(u) ((const char*)g.Bt + ((size_t)(u).grp * g.gsB + (size_t)(u).pn * BM * g.ldb) * 2)
    Unit cur, nxt; int ui = 0;
    if (!S.next(0, cur)) return;
    f32x4 acc[2][2][4][2];
#pragma unroll
    for (int a = 0; a < 2; ++a)
#pragma unroll
        for (int b = 0; b < 2; ++b)
#pragma unroll
            for (int m = 0; m < 4; ++m)
#pragma unroll
                for (int n = 0; n < 2; ++n) acc[a][b][m][n] = (f32x4){0.f, 0.f, 0.f, 0.f};
    bf16x8 At[4][2], B0[2][2], B1[2][2];
    const char* cA = PG8_ABASE(cur); const char* cB = PG8_BBASE(cur);
    PG8_STAGE(PG8_SB(0, 0), cB, voffB); PG8_STAGE(PG8_SB(0, 1), cB + hstepB, voffB); PG8_STAGE(PG8_SA(0, 0), cA, voffA); PG8_STAGE(PG8_SA(0, 1), cA + hstepA, voffA);
    if (wr == 1) PG8_BAR;
    PG8_WAIT_V(2); PG8_BAR;
    PG8_STAGE(PG8_SB(1, 0), cB + kstep, voffB); PG8_STAGE(PG8_SA(1, 0), cA + kstep, voffA); PG8_STAGE(PG8_SB(1, 1), cB + hstepB + kstep, voffB);
    PG8_WAIT_V(6); PG8_BAR;
    for (;;) {
        const bool has_next = S.next(ui + 1, nxt);
        const char* nA = has_next ? PG8_ABASE(nxt) : cA; const char* nB = has_next ? PG8_BBASE(nxt) : cB;
        for (int t = 0; t < nt; t += 2) {
            const bool last = (t == nt - 2);
            const char* a1 = cA + (size_t)(t + 1) * kstep;
            const char* a2 = last ? nA : cA + (size_t)(t + 2) * kstep; const char* b2 = last ? nB : cB + (size_t)(t + 2) * kstep;
            const char* a3 = a2 + kstep; const char* b3 = b2 + kstep;
            PG8_LDB(B0, 0, 0); PG8_LDB(B1, 0, 1); PG8_SCHED; PG8_LDA(At, 0, 0); PG8_STAGE(PG8_SA(1, 1), a1 + hstepA, voffA);
            PG8_WAIT_V(8); PG8_WAIT_L(0); PG8_BAR; PG8_MMA(0, 0, At, B0); PG8_MMA(0, 1, At, B1); PG8_BAR; PG8_SCHED;
            PG8_LDA(At, 0, 1); PG8_STAGE(PG8_SB(0, 0), b2, voffB); PG8_STAGE(PG8_SB(0, 1), b2 + hstepB, voffB); PG8_STAGE(PG8_SA(0, 0), a2, voffA);
            PG8_WAIT_V(8); PG8_WAIT_L(0); PG8_BAR; PG8_MMA(1, 0, At, B0); PG8_MMA(1, 1, At, B1); PG8_BAR; PG8_SCHED;
            PG8_LDB(B0, 1, 0); PG8_LDB(B1, 1, 1); PG8_SCHED; PG8_LDA(At, 1, 0); PG8_STAGE(PG8_SA(0, 1), a2 + hstepA, voffA);
            PG8_WAIT_V(8); PG8_WAIT_L(0); PG8_BAR; PG8_MMA(0, 0, At, B0); PG8_MMA(0, 1, At, B1); PG8_BAR; PG8_SCHED;
            PG8_LDA(At, 1, 1); PG8_STAGE(PG8_SB(1, 0), b3, voffB); PG8_STAGE(PG8_SB(1, 1), b3 + hstepB, voffB); PG8_STAGE(PG8_SA(1, 0), a3, voffA);
            PG8_WAIT_V(8); PG8_WAIT_L(0); PG8_BAR; PG8_MMA(1, 0, At, B0); PG8_MMA(1, 1, At, B1); PG8_BAR; PG8_SCHED;
        }
        if (wr == 0) PG8_BAR;
        E(acc, cur, wr, wc, fr, fq);
        if (!has_next) break;
#pragma unroll
        for (int a = 0; a < 2; ++a)
#pragma unroll
            for (int b = 0; b < 2; ++b)
#pragma unroll
                for (int m = 0; m < 4; ++m)
#pragma unroll
                    for (int n = 0; n < 2; ++n) acc[a][b][m][n] = (f32x4){0.f, 0.f, 0.f, 0.f};
        cur = nxt; cA = nA; cB = nB; ++ui;
        if (wr == 1) PG8_BAR;
    }
    PG8_WAIT_V(0);
    PG8_BAR;
#undef PG8_SA
#undef PG8_SB
#undef PG8_STAGE
#undef PG8_LDA
#undef PG8_LDB
#undef PG8_MMA
#undef PG8_WAIT_V
#undef PG8_WAIT_L
#undef PG8_BAR
#undef PG8_SCHED
#undef PG8_ABASE
#undef PG8_BBASE
}
}
using pg8::Unit;

#define EPI_ROWX(ai, m) (u.pm * 256 + (ai) * 128 + wr * 64 + (m) * 16 + fr)
#define EPI_FOR_M _Pragma("unroll") for (int m = 0; m < 4; ++m)
#define EPI_FOR_BJ _Pragma("unroll") for (int bj = 0; bj < 2; ++bj)
#define EPI_GET8(v, bj) float v[8] = {acc[ai][bj][m][0][0], acc[ai][bj][m][0][1], acc[ai][bj][m][0][2], acc[ai][bj][m][0][3], acc[ai][bj][m][1][0], acc[ai][bj][m][1][1], acc[ai][bj][m][1][2], acc[ai][bj][m][1][3]}
#define EPI_FENCE __builtin_amdgcn_sched_barrier(0)
typedef const f32x4 (&AccRef)[2][2][4][2];
__device__ __forceinline__ void st8f(float* b, unsigned o, const float* v) { GAS f32x4* p = (GAS f32x4*)((GAS float*)b + o); p[0] = (f32x4){v[0], v[1], v[2], v[3]}; p[1] = (f32x4){v[4], v[5], v[6], v[7]}; }
__device__ __forceinline__ void ld8f(const float* b, unsigned o, float* v) { const GAS f32x4* p = (const GAS f32x4*)((const GAS float*)b + o); const f32x4 a = p[0], c = p[1]; v[0] = a[0]; v[1] = a[1]; v[2] = a[2]; v[3] = a[3]; v[4] = c[0]; v[5] = c[1]; v[6] = c[2]; v[7] = c[3]; }
__device__ __forceinline__ u32x4 ld8raw(const bf16_t* b, unsigned o) { return *(const GAS u32x4*)((const GAS bf16_t*)b + o); }
__device__ __forceinline__ void st8b(bf16_t* b, unsigned o, const float* v) { *(GAS u32x4*)((GAS bf16_t*)b + o) = pk8bf(v); }

struct EpiIn {
    const float* ssq; const float* qg; const float* kg;
    float *okp, *ovp, *oks, *ovs;
    bf16_t *QB, *KTP, *VTP, *KTS, *VTS, *GA, *UX, *GS, *GL; float* US;
    __device__ __forceinline__ void operator()(AccRef acc, const Unit& u, int wr, int wc, int fr, int fq) const {
        const int pn = u.pn; const bool smp = (u.pm == MP / 256);
        float rinv[2][4];
        { f32x4 t[2][4];
#pragma unroll
          for (int ai = 0; ai < 2; ++ai) EPI_FOR_M t[ai][m] = *(const GAS f32x4*)((const GAS float*)ssq + (unsigned)(EPI_ROWX(ai, m) * 16 + 4 * fq));
#pragma unroll
          for (int ai = 0; ai < 2; ++ai) EPI_FOR_M { float x = (t[ai][m][0] + t[ai][m][1]) + (t[ai][m][2] + t[ai][m][3]); x += __shfl_xor(x, 16); x += __shfl_xor(x, 32); rinv[ai][m] = __builtin_amdgcn_rsqf(x * (1.0f / D) + EPS); } }
        if (pn < 8) {
            const bool isk = pn >= 4; const float* g = isk ? kg : qg; const float scale = isk ? 1.0f : 0.125f * LOG2E;
            float gv[2][8];
            EPI_FOR_BJ ld8f(g, 32 * bj + 8 * fq, gv[bj]);
            const int ct = (isk ? pn - 4 : pn) * 256 + 64 * wc + 8 * fq;
            const int mapi = ct >> 9, head = (ct >> 6) & 7;
#pragma unroll
            for (int ai = 0; ai < 2; ++ai) EPI_FOR_M { EPI_FENCE; const int row = EPI_ROWX(ai, m); const float ri = rinv[ai][m];
                EPI_GET8(v0, 0); EPI_GET8(v1, 1); float s = 0.f;
#pragma unroll
                for (int j = 0; j < 8; ++j) { v0[j] *= ri; v1[j] *= ri; s += v0[j] * v0[j] + v1[j] * v1[j]; }
                s += __shfl_xor(s, 16); s += __shfl_xor(s, 32);
                const float rn = __builtin_amdgcn_rsqf(s * (1.0f / HD) + EPS) * scale;
#pragma unroll
                for (int j = 0; j < 8; ++j) { v0[j] *= rn * gv[0][j]; v1[j] *= rn * gv[1][j]; }
                if (!isk) { const unsigned qo = (unsigned)(row * D + head * 128 + mapi * 64 + 8 * fq); st8b(QB, qo, v0); st8b(QB, qo + 32, v1); }
                else {
                    if (smp) { const unsigned oo = (unsigned)((row - MP) * D + ct); st8f(oks, oo, v0); st8f(oks, oo + 32, v1); }
                    bf16_t* img; unsigned io; int kv;
                    if (smp) { const int rs = row - MP, b = rs >> 4; kv = rs & 15; img = KTS; io = (unsigned)((((b * NH + head) * 2 + mapi) * NTS + (NTS - 1)) * 4096); }
                    else { const int b = row >> 11, t = row & (T - 1); kv = t & 63; img = KTP; io = (unsigned)((((b * NH + head) * 2 + mapi) * (T / 64) + (t >> 6)) * 4096); }
                    io += (fq >> 1) * 1024 + (fq & 1) * 512 + kv * 8; st8b(img, io, v0); st8b(img, io + 2048, v1);
                }
            }
        } else if (pn < 12) {
#pragma unroll
            for (int ai = 0; ai < 2; ++ai) EPI_FOR_M { EPI_FENCE; const int row = EPI_ROWX(ai, m); const float ri = rinv[ai][m];
                EPI_FOR_BJ { EPI_GET8(v, bj);
#pragma unroll
                    for (int j = 0; j < 8; ++j) v[j] *= ri;
                    const int ct = (pn - 8) * 256 + 128 * bj + 32 * wc + 8 * fq, head = ct >> 7;
                    if (smp) st8f(ovs, (unsigned)((row - MP) * D + ct), v);
                    bf16_t* img; unsigned io; int kv;
                    if (smp) { const int rs = row - MP, b = rs >> 4; kv = rs & 15; img = VTS; io = (unsigned)(((b * NH + head) * NTS + (NTS - 1)) * 8192); }
                    else { const int b = row >> 11, t = row & (T - 1); kv = t & 63; img = VTP; io = (unsigned)(((b * NH + head) * (T / 64) + (t >> 6)) * 8192); }
                    st8b(img, io + wc * 2048 + (kv >> 4) * 512 + (kv & 15) * 32 + 8 * fq, v); } }
        } else if (pn < 16 || (pn >= 20 && pn < 24)) {
            bf16_t* dst = pn < 16 ? GA : GS; const int c0 = (pn < 16 ? pn - 12 : pn - 20) * 256 + 32 * wc + 8 * fq;
#pragma unroll
            for (int ai = 0; ai < 2; ++ai) EPI_FOR_M { EPI_FENCE; const int row = EPI_ROWX(ai, m); const float ri = rinv[ai][m];
                EPI_FOR_BJ { EPI_GET8(v, bj);
#pragma unroll
                    for (int j = 0; j < 8; ++j) v[j] = siluf_(v[j] * ri);
                    st8b(dst, (unsigned)(row * D + c0 + 128 * bj), v); } }
        } else if (pn < 20) {
#pragma unroll
            for (int ai = 0; ai < 2; ++ai) EPI_FOR_M { EPI_FENCE; const int row = EPI_ROWX(ai, m); const float ri = rinv[ai][m];
                EPI_FOR_BJ { EPI_GET8(v, bj);
#pragma unroll
                    for (int j = 0; j < 8; ++j) v[j] *= ri;
                    const int ct = (pn - 16) * 256 + 128 * bj + 32 * wc + 8 * fq;
                    if (smp) st8f(US, (unsigned)((row - MP) * D + ct), v);
                    else st8b(UX, (unsigned)(((ct >> 4) * NPAIR + (row >> 5)) * KX + (row & 31) * GC + (ct & 15)), v); } }
        } else {
            const int c0 = (pn - 24) * 256 + 32 * wc + 8 * fq;
#pragma unroll
            for (int ai = 0; ai < 2; ++ai) EPI_FOR_M { EPI_FENCE; const int row = EPI_ROWX(ai, m); const float ri = rinv[ai][m];
                EPI_FOR_BJ { EPI_GET8(v, bj);
#pragma unroll
                    for (int j = 0; j < 8; ++j) v[j] = sigmoidf_(v[j] * ri);
                    st8b(GL, (unsigned)(row * 2048 + c0 + 128 * bj), v); } }
        }
    }
};
struct EpiS1 { float* HF;
    __device__ __forceinline__ void operator()(AccRef acc, const Unit& u, int wr, int wc, int fr, int fq) const {
#pragma unroll
        for (int ai = 0; ai < 2; ++ai) EPI_FOR_M { const int row = EPI_ROWX(ai, m); EPI_GET8(v, 0); st8f(HF, (unsigned)((u.grp * NPAIR + row) * 128 + 32 * wc + 8 * fq), v); } } };
struct EpiS2 { bf16_t* YS;
    __device__ __forceinline__ void operator()(AccRef acc, const Unit& u, int wr, int wc, int fr, int fq) const {
#pragma unroll
        for (int ai = 0; ai < 2; ++ai) EPI_FOR_M { EPI_FENCE; const int pair = EPI_ROWX(ai, m);
            EPI_FOR_BJ { EPI_GET8(v, bj);
#pragma unroll
                for (int j = 0; j < 8; ++j) v[j] = geluf_(v[j]);
                const int col = u.pn * 256 + 128 * bj + 32 * wc + 8 * fq, jt = col >> 4, no = col & 15;
                st8b(YS, (unsigned)((pair * LC + jt) * D + u.grp * GC + no), v); } } } };
struct EpiAP { const bf16_t* GL; bf16_t* MGA;
    __device__ __forceinline__ void operator()(AccRef acc, const Unit& u, int wr, int wc, int fr, int fq) const {
        const int c0 = u.pn * 256 + 32 * wc + 8 * fq;
        u32x4 gr[2][4][2];
#pragma unroll
        for (int ai = 0; ai < 2; ++ai) EPI_FOR_M EPI_FOR_BJ gr[ai][m][bj] = ld8raw(GL, (unsigned)(EPI_ROWX(ai, m) * 2048 + c0 + 128 * bj));
#pragma unroll
        for (int ai = 0; ai < 2; ++ai) EPI_FOR_M { EPI_FENCE; const int row = EPI_ROWX(ai, m);
            EPI_FOR_BJ { EPI_GET8(v, bj); float g[8]; unpk8bf(gr[ai][m][bj], g);
#pragma unroll
                for (int j = 0; j < 8; ++j) v[j] *= g[j];
                st8b(MGA, (unsigned)(row * D + c0 + 128 * bj), v); } } } };
struct EpiGLU { const bf16_t* YS; const bf16_t* GS; const float* bias; bf16_t* Z;
    __device__ __forceinline__ void operator()(AccRef acc, const Unit& u, int wr, int wc, int fr, int fq) const {
        const int c0 = u.pn * 256 + 32 * wc + 8 * fq;
        float bv[2][8];
        EPI_FOR_BJ ld8f(bias, (unsigned)(c0 + 128 * bj), bv[bj]);
#pragma unroll
        for (int ai = 0; ai < 2; ++ai) { EPI_FENCE; u32x4 yr[4][2], gr[4][2];
            EPI_FOR_M EPI_FOR_BJ { const unsigned o = (unsigned)(EPI_ROWX(ai, m) * D + c0 + 128 * bj); yr[m][bj] = ld8raw(YS, o); gr[m][bj] = ld8raw(GS, o); }
            EPI_FOR_M { const int row = EPI_ROWX(ai, m);
                EPI_FOR_BJ { EPI_GET8(v, bj); float y[8], g[8]; unpk8bf(yr[m][bj], y); unpk8bf(gr[m][bj], g);
#pragma unroll
                    for (int j = 0; j < 8; ++j) v[j] = y[j] * sigmoidf_(v[j] + bv[bj][j]) * g[j];
                    st8b(Z, (unsigned)(row * D + c0 + 128 * bj), v); } } } } };
struct EpiSP { const bf16_t* GL; const bf16_t* MGA; bf16_t* MG;
    __device__ __forceinline__ void operator()(AccRef acc, const Unit& u, int wr, int wc, int fr, int fq) const {
        const int c0 = u.pn * 256 + 32 * wc + 8 * fq;
#pragma unroll
        for (int ai = 0; ai < 2; ++ai) { EPI_FENCE; u32x4 ar[4][2], gr[4][2];
            EPI_FOR_M EPI_FOR_BJ { const int row = EPI_ROWX(ai, m); gr[m][bj] = ld8raw(GL, (unsigned)(row * 2048 + D + c0 + 128 * bj)); ar[m][bj] = ld8raw(MGA, (unsigned)(row * D + c0 + 128 * bj)); }
            EPI_FOR_M { const int row = EPI_ROWX(ai, m);
                EPI_FOR_BJ { EPI_GET8(v, bj); float g[8], a[8]; unpk8bf(gr[m][bj], g); unpk8bf(ar[m][bj], a);
#pragma unroll
                    for (int j = 0; j < 8; ++j) v[j] = a[j] + g[j] * v[j];
                    st8b(MG, (unsigned)(row * D + c0 + 128 * bj), v); } } } } };
struct EpiOut { bf16_t* XB; float* y; float* ssq; int next;
    __device__ __forceinline__ void operator()(AccRef acc, const Unit& u, int wr, int wc, int fr, int fq) const {
        const int c0 = u.pn * 256 + 32 * wc + 8 * fq;
        u32x4 xr[2][4][2];
#pragma unroll
        for (int ai = 0; ai < 2; ++ai) EPI_FOR_M EPI_FOR_BJ xr[ai][m][bj] = ld8raw(XB, (unsigned)(EPI_ROWX(ai, m) * D + c0 + 128 * bj));
#pragma unroll
        for (int ai = 0; ai < 2; ++ai) EPI_FOR_M { EPI_FENCE; const int row = EPI_ROWX(ai, m); float s = 0.f;
            EPI_FOR_BJ { EPI_GET8(v, bj); float x[8]; unpk8bf(xr[ai][m][bj], x);
#pragma unroll
                for (int j = 0; j < 8; ++j) { v[j] += x[j]; s += v[j] * v[j]; }
                if (next) st8b(XB, (unsigned)(row * D + c0 + 128 * bj), v); else st8f(y, (unsigned)(row * D + c0 + 128 * bj), v); }
            if (next) { s += __shfl_xor(s, 16); s += __shfl_xor(s, 32); if (fq == 0) ((GAS float*)ssq)[(unsigned)(row * 16 + u.pn * 4 + wc)] = s; } } } };

constexpr int AT_SLOT = 32768, AT_CB = 65536, AT_LS = 131072;
struct AttnJob { const bf16_t* Q; const bf16_t* K; const bf16_t* V; const bf16_t* GA; bf16_t* OA; const float* subg; int kmap; int nt; int qrow0, qpos0, head, sample; float lam, shift2, outscale; };
__device__ __forceinline__ int crow(int r, int hi) { return (r & 3) + 8 * (r >> 2) + 4 * hi; }
struct BgJob { const bf16_t* KTP; const bf16_t* VTP; float* okp; float* ovp; const float* ck; const float* cv; bf16_t* KTS; bf16_t* VTS; unsigned base; };
__device__ __forceinline__ void bg_issue(const BgJob& B, unsigned ib, int tid, u32x4& d0, u32x4& d1) {
    const unsigned kind = ib >> 21, i = (ib & 0x1FFFFFu) + (unsigned)tid;
    if (kind == 0) { const unsigned lp = i & 63, h = (i >> 6) & 7, m = (i >> 9) & 1, t = ((i >> 10) & 255) * 8 + (lp & 7), b = i >> 18, d8 = lp >> 3;
        d0 = ld8raw(B.KTP, (((b * 8 + h) * 2 + m) * 32 + (t >> 6)) * 4096 + (d8 >> 1) * 1024 + (d8 & 1) * 512 + (t & 63) * 8); }
    else if (kind == 1) { const unsigned lp = i & 63, h = (i >> 6) & 7, t = ((i >> 9) & 511) * 4 + (lp >> 4), b = i >> 18, e8 = lp & 15, kv = t & 63;
        d0 = ld8raw(B.VTP, ((b * 8 + h) * 32 + (t >> 6)) * 8192 + (e8 >> 2) * 2048 + (kv >> 4) * 512 + (kv & 15) * 32 + (e8 & 3) * 8); }
    else if (kind < 4) { const GAS u32x4* p = (const GAS u32x4*)((const GAS float*)(kind == 2 ? B.ck : B.cv) + i * 8); d0 = p[0]; d1 = p[1]; }
}
__device__ __forceinline__ void bg_commit(const BgJob& B, unsigned ib, int tid, const u32x4& d0, const u32x4& d1) {
    const unsigned kind = ib >> 21, i = (ib & 0x1FFFFFu) + (unsigned)tid;
    if (kind == 0) { const unsigned lp = i & 63, h = (i >> 6) & 7, m = (i >> 9) & 1, t = ((i >> 10) & 255) * 8 + (lp & 7), b = i >> 18, d8 = lp >> 3; float v[8]; unpk8bf(d0, v);
        st8f(B.okp, (b * T + t) * D + m * 512 + h * 64 + d8 * 8, v); }
    else if (kind == 1) { const unsigned lp = i & 63, h = (i >> 6) & 7, t = ((i >> 9) & 511) * 4 + (lp >> 4), b = i >> 18, e8 = lp & 15; float v[8]; unpk8bf(d0, v);
        st8f(B.ovp, (b * T + t) * D + h * 128 + e8 * 8, v); }
    else if (kind < 4) { const unsigned c8 = i & 127, t = (i >> 7) & (PAST - 1), b = i >> 17, col = c8 * 8;
        const float v[8] = {__uint_as_float(d0.x), __uint_as_float(d0.y), __uint_as_float(d0.z), __uint_as_float(d0.w), __uint_as_float(d1.x), __uint_as_float(d1.y), __uint_as_float(d1.z), __uint_as_float(d1.w)};
        if (kind == 2) { const unsigned mapi = col >> 9, head = (col >> 6) & 7, d8 = (col & 63) >> 3;
            st8b(B.KTS, (((b * NH + head) * 2 + mapi) * NTS + (t >> 6)) * 4096 + (d8 >> 1) * 1024 + (d8 & 1) * 512 + (t & 63) * 8, v); }
        else { const unsigned head = col >> 7, e = col & 127, kv = t & 63;
            st8b(B.VTS, ((b * NH + head) * NTS + (t >> 6)) * 8192 + (e >> 5) * 2048 + (kv >> 4) * 512 + (kv & 15) * 32 + (e & 31), v); } }
}
template <bool BG>
__device__ __forceinline__ void attn_unit(LAS unsigned char* lds, const AttnJob& J_, int tid_, const BgJob& Bg) {
    AttnJob J = J_; asm volatile("" : "+s"(J.head), "+s"(J.qpos0), "+s"(J.qrow0), "+s"(J.sample), "+s"(J.nt));
    int tid = tid_; asm volatile("" : "+v"(tid));
    const int lane = tid & 63, r32 = lane & 31, hi = lane >> 5; const int wid = __builtin_amdgcn_readfirstlane(tid >> 6), mapi = wid >> 2, sub = wid & 3;
    const float slope2 = __builtin_amdgcn_exp2f(-(float)(J.head + 1)) * LOG2E;
    const int tq0 = J.qpos0 + 32 * sub, tq = tq0 + (J.sample ? (r32 & 15) : r32);
    const int mychunk = tq0 >> 6;
    const int ntl = J.sample ? (sub == 0 ? J.nt : 0) : (mychunk + 1);
    const int qrow = J.qrow0 + 32 * sub + (J.sample ? (r32 & 15) : r32);
    const unsigned loff = (unsigned)lane * 16u;
    const GAS char* pbase; size_t pstr;
    if (wid < 4) { pbase = (const GAS char*)J.K + ((size_t)(wid >> 1) * J.kmap + (size_t)(wid & 1) * 2048) * 2; pstr = 8192; }
    else { pbase = (const GAS char*)J.V + (size_t)(wid - 4) * 4096; pstr = 16384; }
#define AT_DMA(t, sloff) do { const GAS char* p_ = pbase + (size_t)(t) * pstr; _Pragma("unroll") for (int _i = 0; _i < 4; ++_i) \
        __builtin_amdgcn_global_load_lds((const GAS unsigned*)(p_ + _i * 1024 + loff), (LAS unsigned*)(lds + (sloff) + (wid * 4 + _i) * 1024), 16, 0, 0); } while (0)
    AT_DMA(0, 0);
    if (J.nt > 1) AT_DMA(1, AT_SLOT);
    bf16x8 qr[4];
#pragma unroll
    for (int d0 = 0; d0 < 4; ++d0) qr[d0] = *(const bf16x8*)(J.Q + (size_t)qrow * D + J.head * 128 + mapi * 64 + d0 * 16 + hi * 8);
    f32x16 o[4];
#pragma unroll
    for (int e = 0; e < 4; ++e) o[e] = (f32x16){};
    float lsum = 0.f;
    const int koff = mapi * 8192 + hi * 1024 + r32 * 16;
    const int voff = 16384 + ((lane >> 4) & 1) * 32 + (lane & 3) * 8 + (4 * hi + ((lane & 15) >> 2)) * 64;
#define AT_QK(P0, P1, sloff) do { const LAS unsigned char* kb_ = lds + (sloff) + koff; bf16x8 kf_[4][2]; \
        _Pragma("unroll") for (int d0 = 0; d0 < 4; ++d0) { kf_[d0][0] = *(const LAS bf16x8*)(kb_ + d0 * 2048); kf_[d0][1] = *(const LAS bf16x8*)(kb_ + d0 * 2048 + 512); } \
        _Pragma("unroll") for (int d0 = 0; d0 < 4; ++d0) { \
            P0 = __builtin_amdgcn_mfma_f32_32x32x16_bf16(kf_[d0][0], qr[d0], d0 == 0 ? (f32x16){} : P0, 0, 0, 0); \
            P1 = __builtin_amdgcn_mfma_f32_32x32x16_bf16(kf_[d0][1], qr[d0], d0 == 0 ? (f32x16){} : P1, 0, 0, 0); } } while (0)
#define AT_VRD(ks) do { _Pragma("unroll") for (int eb = 0; eb < 4; ++eb) { \
        asm volatile("ds_read_b64_tr_b16 %0, %1 offset:%2" : "=v"(vlo[eb][ks]) : "v"(va), "i"(eb * 4096 + (ks) * 1024) : "memory"); \
        asm volatile("ds_read_b64_tr_b16 %0, %1 offset:%2" : "=v"(vhi[eb][ks]) : "v"(va), "i"(eb * 4096 + (ks) * 1024 + 512) : "memory"); } } while (0)
#define AT_PV(ks) do { _Pragma("unroll") for (int eb = 0; eb < 4; ++eb) { \
        const bf16x8 vf = {vlo[eb][ks][0], vlo[eb][ks][1], vlo[eb][ks][2], vlo[eb][ks][3], vhi[eb][ks][0], vhi[eb][ks][1], vhi[eb][ks][2], vhi[eb][ks][3]}; \
        o[eb] = __builtin_amdgcn_mfma_f32_32x32x16_bf16(__builtin_bit_cast(bf16x8, pw[ks]), vf, o[eb], 0, 0, 0); } } while (0)
#define AT_STEP(P0, P1, N0, N1, t) do { \
        if ((t) > 0) { VM_WAIT(); __syncthreads(); }                             \
        if (BG) { if ((t) > 0) bg_commit(Bg, bgb + ((t) - 1) * 512, tid, bd0, bd1); bg_issue(Bg, bgb + (t) * 512, tid, bd0, bd1); } \
        if ((t) + 2 < J.nt) AT_DMA((t) + 2, s_free); \
        if ((t) < ntl) { \
            if ((t) + 1 < ntl) AT_QK(N0, N1, s_nxt); \
            s16x4 vlo[4][4], vhi[4][4]; \
            const unsigned va = (unsigned)(uintptr_t)(lds + s_cur + voff);       \
            AT_VRD(0); \
            __builtin_amdgcn_sched_barrier(0); \
            if ((t) < mychunk) {                                                 \
                const float base = slope2 * (float)(64 * (t) + 4 * hi - tq) - J.shift2, base1 = base + 32.0f * slope2; \
                _Pragma("unroll") for (int r = 0; r < 16; ++r) { const float kr = slope2 * (float)((r & 3) + 8 * (r >> 2)); P0[r] += kr + base; P1[r] += kr + base1; } \
            } else { \
                _Pragma("unroll") for (int r = 0; r < 16; ++r) { const int kr = crow(r, hi); const float d0 = (float)(64 * (t) + kr - tq); \
                    P0[r] += -slope2 * __builtin_fabsf(d0) - J.shift2; P1[r] += -slope2 * __builtin_fabsf(d0 + 32.0f) - J.shift2; \
                    if (J.sample) { if (kr >= DS) P0[r] = -1e30f; P1[r] = -1e30f; } } \
            } \
            float sa = 0.f, sb = 0.f; \
            _Pragma("unroll") for (int r = 0; r < 16; ++r) { P0[r] = __builtin_amdgcn_exp2f(P0[r]); P1[r] = __builtin_amdgcn_exp2f(P1[r]); sa += P0[r]; sb += P1[r]; } \
            lsum += sa + sb; \
            u32x4 pw[4]; \
            _Pragma("unroll") for (int k = 0; k < 4; ++k) { pw[0][k] = pk2bf(P0[2 * k], P0[2 * k + 1]); pw[1][k] = pk2bf(P0[8 + 2 * k], P0[9 + 2 * k]); pw[2][k] = pk2bf(P1[2 * k], P1[2 * k + 1]); pw[3][k] = pk2bf(P1[8 + 2 * k], P1[9 + 2 * k]); } \
            asm volatile("s_waitcnt lgkmcnt(0)" ::: "memory"); __builtin_amdgcn_sched_barrier(0); \
            AT_VRD(1); AT_PV(0); asm volatile("s_waitcnt lgkmcnt(0)" ::: "memory"); __builtin_amdgcn_sched_barrier(0); \
            AT_VRD(2); AT_PV(1); asm volatile("s_waitcnt lgkmcnt(0)" ::: "memory"); __builtin_amdgcn_sched_barrier(0); \
            AT_VRD(3); AT_PV(2); asm volatile("s_waitcnt lgkmcnt(0)" ::: "memory"); __builtin_amdgcn_sched_barrier(0); \
            AT_PV(3); \
        } \
        { const int tmp_ = s_cur; s_cur = s_nxt; s_nxt = s_free; s_free = tmp_; } } while (0)
    int s_cur = 0, s_nxt = AT_SLOT, s_free = 2 * AT_SLOT;
    u32x4 bd0 = {0u, 0u, 0u, 0u}, bd1 = {0u, 0u, 0u, 0u}; unsigned bgb = Bg.base; asm volatile("" : "+s"(bgb));
    f32x16 a0, a1, b0, b1;
    VM_WAIT(); __syncthreads();
    if (ntl > 0) AT_QK(a0, a1, 0);
    for (int t = 0; t < J.nt; t += 2) {
        AT_STEP(a0, a1, b0, b1, t);
        if (t + 1 < J.nt) AT_STEP(b0, b1, a0, a1, t + 1);
    }
#undef AT_DMA
#undef AT_QK
#undef AT_STEP
#undef AT_VRD
#undef AT_PV
    lsum += __shfl_xor(lsum, 32);
    LAS float* ls = (LAS float*)(lds + AT_LS) + wid * 32;
    LAS float* cb = (LAS float*)(lds + AT_CB) + sub * 4096;
    const bool act = ntl > 0;
    __syncthreads();
    if (BG) bg_commit(Bg, bgb + (J.nt - 1) * 512, tid, bd0, bd1);
    if (act) {
        if (hi == 0) ls[r32] = lsum;
        LDS_WAIT();
        float f[16];
#pragma unroll
        for (int r = 0; r < 16; ++r) f[r] = (mapi ? J.lam : 1.0f) * __builtin_amdgcn_rcpf(ls[crow(r, hi)]);
#pragma unroll
        for (int eb = 0; eb < 4; ++eb)
#pragma unroll
            for (int r = 0; r < 16; ++r) o[eb][r] *= f[r];
        if (mapi) {
#pragma unroll
            for (int eb = 0; eb < 4; ++eb)
#pragma unroll
                for (int r = 0; r < 16; ++r) cb[(eb * 16 + r) * 64 + lane] = o[eb][r];
        }
    }
    __syncthreads();
    if (act && mapi == 0) {
        float ss[16];
#pragma unroll
        for (int r = 0; r < 16; ++r) ss[r] = 0.f;
#pragma unroll
        for (int eb = 0; eb < 4; ++eb)
#pragma unroll
            for (int r = 0; r < 16; ++r) { o[eb][r] -= cb[(eb * 16 + r) * 64 + lane]; ss[r] += o[eb][r] * o[eb][r]; }
#pragma unroll
        for (int r = 0; r < 16; ++r) { float s = ss[r]; s += __shfl_xor(s, 1); s += __shfl_xor(s, 2); s += __shfl_xor(s, 4); s += __shfl_xor(s, 8); s += __shfl_xor(s, 16);
            ss[r] = __builtin_amdgcn_rsqf(s * (1.0f / VD) + EPS) * J.outscale; }
#pragma unroll
        for (int eb = 0; eb < 4; ++eb) { const int e = eb * 32 + r32; const float sg = J.subg[e];
#pragma unroll
            for (int r = 0; r < 16; ++r) { const int qi = crow(r, hi);
                if (!J.sample || qi < DS) { const size_t idx = (size_t)(J.qrow0 + 32 * sub + qi) * D + J.head * VD + e;
                    J.OA[idx] = f2bf(o[eb][r] * ss[r] * sg * bf2f(J.GA[idx])); } } }
    }
}

#define XB_TMO      128
#define XB_XCNT(j)  (256  + 64 * (j))
#define XB_XSUB(j)  (1280 + 64 * (j))
#define XB_XGEN(j)  (2304 + 64 * (j))
#define XB_TOP      3328
#define XB_TOPGEN   3392
#define XCD_BAR_WORDS 3456
#define XB_SPIN_CAP (1u << 20)
__device__ __forceinline__ unsigned xb_ld(unsigned* p)              { return __hip_atomic_load(p, __ATOMIC_RELAXED, __HIP_MEMORY_SCOPE_AGENT); }
__device__ __forceinline__ unsigned xb_add(unsigned* p, unsigned v) { return __hip_atomic_fetch_add(p, v, __ATOMIC_RELAXED, __HIP_MEMORY_SCOPE_AGENT); }
__device__ __forceinline__ unsigned xb_xcc_id() { return (unsigned)__builtin_amdgcn_s_getreg((3 << 11) | 20) & 0xFu; }
#define XB_SPIN(cond, bar) do { unsigned _sp = 0; while (cond) { __builtin_amdgcn_s_sleep(1); \
    if ((++_sp & 255u) == 0u) { if (xb_ld(&(bar)[XB_TMO])) break; if (_sp > XB_SPIN_CAP) { atomicAdd(&(bar)[XB_TMO], 1u); break; } } } } while (0)
struct XcdBarrier { unsigned* bar; unsigned x; volatile LAS unsigned* st; };
__device__ __forceinline__ XcdBarrier xcd_barrier_post(unsigned* bar, volatile LAS unsigned* st, int tid) {
    XcdBarrier b; b.bar = bar; b.x = xb_xcc_id(); b.st = st;
    if (tid == 0) (void)xb_add(&bar[XB_XCNT(b.x)], 1u);
    return b;
}
__device__ __forceinline__ void xcd_barrier_complete(unsigned* bar, unsigned x, unsigned& nloc, unsigned& nx) {
    const unsigned G = gridDim.x * gridDim.y * gridDim.z;
    unsigned sum, cnt, mine, sp = 0u;
    for (;;) {
        sum = 0u; cnt = 0u; mine = 0u;
#pragma unroll
        for (unsigned j = 0; j < 16; ++j) { const unsigned c = xb_ld(&bar[XB_XCNT(j)]); sum += c; cnt += (c > 0u) ? 1u : 0u; mine = (j == x) ? c : mine; }
        if (sum == G) break;
        __builtin_amdgcn_s_sleep(1);
        if ((++sp & 255u) == 0u) { if (xb_ld(&bar[XB_TMO])) break; if (sp > XB_SPIN_CAP) { atomicAdd(&bar[XB_TMO], 1u); break; } }
    }
    nloc = mine > 0u ? mine : 1u; nx = cnt > 0u ? cnt : 1u;
}
__device__ __forceinline__ void xcd_barrier(const XcdBarrier& b, int wave0) {
    asm volatile("s_waitcnt vmcnt(0)" ::: "memory");
    __syncthreads();
    if (wave0 * 64 + lane_id() == 0) {
        unsigned* bar = b.bar; unsigned bx_ = b.x; asm volatile("" : "+s"(bar), "+s"(bx_));
        __builtin_amdgcn_s_waitcnt(0);
        unsigned nloc = b.st[0], nx = b.st[1];
        if (nloc == 0u) { xcd_barrier_complete(bar, bx_, nloc, nx); b.st[0] = nloc; b.st[1] = nx; }
        const unsigned old = xb_add(&bar[XB_XSUB(bx_)], 1u);
        const unsigned gen = old / nloc;
        if (old + 1u == (gen + 1u) * nloc) {
            __builtin_amdgcn_fence(__ATOMIC_RELEASE, "agent");
            asm volatile("s_waitcnt vmcnt(0)" ::: "memory");
            const unsigned og = xb_add(&bar[XB_TOP], 1u);
            const unsigned tg = og / nx;
            if (og + 1u == (tg + 1u) * nx) xb_add(&bar[XB_TOPGEN], 1u);
            else XB_SPIN(xb_ld(&bar[XB_TOPGEN]) == tg, bar);
            __builtin_amdgcn_fence(__ATOMIC_ACQUIRE, "agent");
            xb_add(&bar[XB_XGEN(bx_)], 1u);
            asm volatile("s_waitcnt vmcnt(0)" ::: "memory");
        } else {
            XB_SPIN(xb_ld(&bar[XB_XGEN(bx_)]) == gen, bar);
            __builtin_amdgcn_fence(__ATOMIC_ACQUIRE, "agent");
            asm volatile("s_waitcnt vmcnt(0)" ::: "memory");
        }
    }
    __syncthreads();
}

#ifndef PHM
#define PHM 0xFFFF
#endif
#define PH(k) ((PHM >> (k)) & 1)
#ifndef REP
#define REP -1
#endif
#define REPN(k) ((REP == (k)) ? 2 : 1)
constexpr int NWAVES = 8, NTHREADS = 512;
constexpr int LDS_BYTES = 147456, MISC_OFF = 131072 + 1024 + 320;
struct Args { const float* in[28]; float* out; unsigned char* ws; };

__device__ __forceinline__ float wave_sum(float v) {
#pragma unroll
    for (int o = 1; o < 64; o <<= 1) v += __shfl_xor(v, o);
    return v;
}
__device__ __forceinline__ void transpose_item(const float* W, int K, int N, bf16_t* WT, LAS float* scr, int item, int lane, const float* kscale, bool headperm) {
    const int nblk = N / 32, kb = item / nblk, nb = item % nblk, k0 = 64 * kb, n0 = 32 * nb;
#pragma unroll 8
    for (int i = 0; i < 32; ++i) { const int kk = 2 * i + (lane >> 5); float v = W[(size_t)(k0 + kk) * N + n0 + (lane & 31)]; if (kscale) v *= kscale[k0 + kk]; scr[kk * 33 + (lane & 31)] = v; }
    LDS_WAIT(); asm volatile("" ::: "memory");
    int rbase = n0; if (headperm && n0 < 2048) { const int l = n0 & 255; rbase = (n0 & ~255) + 128 * ((l >> 5) & 1) + 32 * (l >> 6); }
    const int c = lane & 7;
#pragma unroll
    for (int j = 0; j < 4; ++j) { const int n = (lane >> 3) + 8 * j; const LAS float* s = scr + (8 * c) * 33 + n;
        u32x4 o; o.x = pk2bf(s[0 * 33], s[1 * 33]); o.y = pk2bf(s[2 * 33], s[3 * 33]); o.z = pk2bf(s[4 * 33], s[5 * 33]); o.w = pk2bf(s[6 * 33], s[7 * 33]);
        *(u32x4*)(WT + (size_t)(rbase + n) * K + k0 + 8 * c) = o; }
    LDS_WAIT(); asm volatile("" ::: "memory");
}

__device__ __forceinline__ void tables_prep(LAS float* AP, LAS float* BB, LAS float* CT, const __attribute__((address_space(4))) Args* Ap, int l, int g, int tid, bool want_bb, float* a32) {
    const float* lre = Ap->in[16] + (size_t)l * NG * SP; const float* lim = Ap->in[17] + (size_t)l * NG * SP; const float* ldt = Ap->in[18] + (size_t)l * NG;
    const float* cre = Ap->in[21] + (size_t)l * NG * GC * SP; const float* cim = Ap->in[22] + (size_t)l * NG * GC * SP;
    {
        const int p = tid & 63, t0 = tid >> 6; const float lr = lre[g * SP + p], li = lim[g * SP + p], dt = __expf(ldt[g]);
        for (int tau = t0; tau <= 32; tau += 8) { const float mg = __expf(lr * dt * (float)tau); float tr = li * dt * (float)tau * 0.15915494309189535f; tr -= rintf(tr);
            AP[(tau * 64 + p) * 2] = mg * __builtin_amdgcn_cosf(tr); AP[(tau * 64 + p) * 2 + 1] = mg * __builtin_amdgcn_sinf(tr); }
    }
    for (int i = tid; i < GC * SP; i += NTHREADS) { CT[i * 2] = cre[(size_t)g * GC * SP + i]; CT[i * 2 + 1] = cim[(size_t)g * GC * SP + i]; }
    __syncthreads();
    if (want_bb && tid < 64) { const int p = tid; const float lr = lre[g * SP + p], li = lim[g * SP + p];
        const float* bre = Ap->in[19] + (size_t)l * NG * SP * GC; const float* bim = Ap->in[20] + (size_t)l * NG * SP * GC;
        const float ar = AP[(64 + p) * 2], ai = AP[(64 + p) * 2 + 1], zr = ar - 1.0f, zi = ai, den = lr * lr + li * li;
        const float wre = (zr * lr + zi * li) / den, wim = (zi * lr - zr * li) / den;
        for (int n = 0; n < GC; ++n) { const float br = bre[(g * SP + p) * GC + n], bi = bim[(g * SP + p) * GC + n]; BB[(p * GC + n) * 2] = wre * br - wim * bi; BB[(p * GC + n) * 2 + 1] = wre * bi + wim * br; }
        a32[(size_t)(g * SP + p) * 2] = AP[(32 * 64 + p) * 2]; a32[(size_t)(g * SP + p) * 2 + 1] = AP[(32 * 64 + p) * 2 + 1];
    }
}
__device__ __forceinline__ void tables_gen(LAS unsigned char* lds, const __attribute__((address_space(4))) Args* Ap, int l, int g, int tid) {
    LAS float* AP = (LAS float*)lds;
    LAS float* BB = AP + 33 * 64 * 2;
    LAS float* CT = BB + 64 * 16 * 2;
    const float* dsk = Ap->in[23] + (size_t)l * D;
    __syncthreads();
    tables_prep(AP, BB, CT, Ap, l, g, tid, true, (float*)(Ap->ws + WS_SCAL) + SC_A32 + (size_t)l * NG * SP * 2);
    __syncthreads();
    {
        const int tau = tid >> 4, no = tid & 15; float a[GC];
#pragma unroll
        for (int n = 0; n < GC; ++n) a[n] = 0.f;
        for (int p = 0; p < SP; ++p) { const f32x2 c = *(const LAS f32x2*)(CT + (no * SP + p) * 2), w = *(const LAS f32x2*)(AP + (tau * 64 + p) * 2);
            const float xr = c[0] * w[0] - c[1] * w[1], xi = c[0] * w[1] + c[1] * w[0];
#pragma unroll
            for (int n2 = 0; n2 < GC / 2; ++n2) { const f32x4 b = *(const LAS f32x4*)(BB + (p * GC + 2 * n2) * 2); a[2 * n2] += xr * b[0] - xi * b[1]; a[2 * n2 + 1] += xr * b[2] - xi * b[3]; } }
        if (tau == 0) { const float dv = dsk[g * GC + no];
#pragma unroll
            for (int n = 0; n < GC; ++n) if (n == no) a[n] += dv; }
        float* kcg = (float*)(Ap->ws + WS_KCG) + ((size_t)(l * NG + g) * LC * GC + tid) * GC;
#pragma unroll
        for (int n4 = 0; n4 < 4; ++n4) *(GAS f32x4*)((GAS float*)kcg + 4 * n4) = (f32x4){a[4 * n4], a[4 * n4 + 1], a[4 * n4 + 2], a[4 * n4 + 3]};
    }
    bf16_t* BT1 = (bf16_t*)(Ap->ws + WS_BT1) + ((size_t)l * (NG + 1) + g) * 128 * (LC * GC);
    for (int ch = tid; ch < 128 * 64; ch += NTHREADS) {
        const int row = ch >> 6, k8 = ch & 63, part = row >> 6, p = row & 63, k = k8 * 8, s = k >> 4, ni0 = k & 15; float v[8];
        const float pr = AP[((31 - s) * 64 + p) * 2], pim = AP[((31 - s) * 64 + p) * 2 + 1];
#pragma unroll
        for (int i = 0; i < 8; ++i) { const float br = BB[(p * GC + ni0 + i) * 2], bi = BB[(p * GC + ni0 + i) * 2 + 1]; v[i] = part == 0 ? (pr * br - pim * bi) : (pr * bi + pim * br); }
        st8b(BT1, (unsigned)(row * (LC * GC) + k), v);
    }
    __syncthreads();
}
__device__ __forceinline__ void tables_expand(LAS unsigned char* lds, const __attribute__((address_space(4))) Args* Ap, int l, int unit, int tid) {
    const int g = unit >> 2, q4 = unit & 3;
    LAS float* AP = (LAS float*)lds;
    LAS float* BB = AP + 33 * 64 * 2;
    LAS float* CT = BB + 64 * 16 * 2;
    LAS float* KC = CT + 16 * 64 * 2;
    __syncthreads();
    { const float* kcg = (const float*)(Ap->ws + WS_KCG) + (size_t)(l * NG + g) * LC * GC * GC;
      for (int i = tid; i < LC * GC * GC / 4; i += NTHREADS) *(LAS f32x4*)(KC + 4 * i) = *(const GAS f32x4*)((const GAS float*)kcg + 4 * i); }
    tables_prep(AP, BB, CT, Ap, l, g, tid, false, nullptr);
    __syncthreads();
    bf16_t* BT2 = (bf16_t*)(Ap->ws + WS_BT2) + (size_t)g * (LC * GC) * KX;
    for (int ch = tid; ch < 128 * (KX / 8); ch += NTHREADS) {
        const int rl = ch / (KX / 8), k8 = ch % (KX / 8), row = q4 * 128 + rl, j = row >> 4, no = row & 15, k = k8 * 8; float v[8];
        if (k < LC * GC) { const int s = k >> 4, ni0 = k & 15, tau = j - s;
            if (tau >= 0) { const f32x4 a = *(const LAS f32x4*)(KC + (tau * GC + no) * GC + ni0), b = *(const LAS f32x4*)(KC + (tau * GC + no) * GC + ni0 + 4);
                v[0] = a[0]; v[1] = a[1]; v[2] = a[2]; v[3] = a[3]; v[4] = b[0]; v[5] = b[1]; v[6] = b[2]; v[7] = b[3]; }
            else {
#pragma unroll
                for (int i = 0; i < 8; ++i) v[i] = 0.f; }
        } else { const int pi0 = k - LC * GC, part = pi0 >> 6, p0 = pi0 & 63;
#pragma unroll
            for (int i = 0; i < 8; ++i) { const int p = p0 + i; const float cr = CT[(no * SP + p) * 2], ci = CT[(no * SP + p) * 2 + 1], pr = AP[((j + 1) * 64 + p) * 2], pim = AP[((j + 1) * 64 + p) * 2 + 1];
                v[i] = part == 0 ? (cr * pr - ci * pim) : -(cr * pim + ci * pr); } }
        st8b(BT2, (unsigned)(row * KX + k), v);
    }
    __syncthreads();
}

typedef const __attribute__((address_space(4))) Args* ArgsP;
__device__ __forceinline__ ArgsP fresh_args() { ArgsP p = (ArgsP)__builtin_amdgcn_kernarg_segment_ptr(); asm volatile("" : "+s"(p)); return p; }
#define WSP(T, off) ((T*)(ws + (off)))
__global__ void __launch_bounds__(NTHREADS, 2) mega_fwd(Args A_unused) {
    extern __shared__ __attribute__((aligned(16))) unsigned char lds_raw[];
    LAS unsigned char* lds = (LAS unsigned char*)lds_raw;
    volatile LAS unsigned* MISC = (volatile LAS unsigned*)(lds + MISC_OFF);
    const int G0 = gridDim.x, bx0 = blockIdx.x;
    const int wave0 = __builtin_amdgcn_readfirstlane((int)threadIdx.x >> 6);
    if (wave0 == 0 && lane_id() < 32) MISC[lane_id()] = 0u;
    __syncthreads();
    XcdBarrier bar = xcd_barrier_post((unsigned*)(fresh_args()->ws + WS_CTL) + 4096, MISC + 8, wave0 * 64 + lane_id());
#define PHASE_BEGIN const ArgsP A = fresh_args(); unsigned char* const ws = A->ws; int tid = wave0 * 64 + lane_id(); asm volatile("" : "+v"(tid)); \
    int G = G0, bx = bx0; asm volatile("" : "+s"(G), "+s"(bx)); const int vcu = (G % 8 == 0) ? (bx % 8) * (G / 8) + bx / 8 : bx; \
    const int lane = tid & 63, wave = __builtin_amdgcn_readfirstlane(tid >> 6), gw = vcu * NWAVES + wave, NGW = G * NWAVES; (void)lane; (void)gw; (void)NGW; (void)ws; (void)vcu;

#if PH(0)
for (int rep_ = 0; rep_ < REPN(0); ++rep_)
    {
        PHASE_BEGIN
        bf16_t* XB = WSP(bf16_t, WS_XB); float* SSQ = WSP(float, WS_SSQ); float* scal = WSP(float, WS_SCAL); bf16_t* KTS = WSP(bf16_t, WS_KTS); bf16_t* VTS = WSP(bf16_t, WS_VTS);
        LAS float* scr = (LAS float*)(lds + wave * 16384);
        constexpr int I_IN = (D / 64) * (INC / 32), I_SM = (D / 64) * (D / 32), I_L = I_IN + 4 * I_SM;
        for (int it = gw; it < DEPTH * I_L; it += NGW) {
            const int l = it / I_L; int r = it % I_L;
            if (r < I_IN) { transpose_item(A->in[7] + (size_t)l * D * INC, D, INC, WSP(bf16_t, WS_WIN) + (size_t)l * INC * D, scr, r, lane, A->in[6] + l * D, true); continue; }
            r -= I_IN; const int w = r / I_SM; r %= I_SM;
            const float* src = (w == 0 ? A->in[15] : w == 1 ? A->in[24] : w == 2 ? A->in[26] : A->in[27]) + (size_t)l * D * D;
            transpose_item(src, D, D, WSP(bf16_t, WS_WSM) + (size_t)(l * 4 + w) * D * D, scr, r, lane, nullptr, false);
        }
        for (int m = gw; m < MT; m += NGW) {
            const float* xr = (m < MP ? A->in[0] + (size_t)m * D : A->in[1] + (size_t)(m - MP) * D); float s = 0.f;
#pragma unroll
            for (int j = 0; j < 4; ++j) { const f32x4 v = *(const f32x4*)(xr + j * 256 + lane * 4); s += (v[0] * v[0] + v[1] * v[1]) + (v[2] * v[2] + v[3] * v[3]);
                u32x2 w; w.x = pk2bf(v[0], v[1]); w.y = pk2bf(v[2], v[3]); *(u32x2*)(XB + (size_t)m * D + j * 256 + lane * 4) = w; }
            s = wave_sum(s);
            if (lane < 16) SSQ[(size_t)m * 16 + lane] = lane == 0 ? s : 0.f;
        }
        if (bx == 0 && wave < DEPTH) {
            const int l = wave; const float a = A->in[10][l * HD + lane] * A->in[11][l * HD + lane], b = A->in[12][l * HD + lane] * A->in[13][l * HD + lane];
            const float s1 = wave_sum(a), s2 = wave_sum(b);
            float mq = __builtin_fabsf(A->in[8][l * HD + lane]), mk = __builtin_fabsf(A->in[9][l * HD + lane]);
#pragma unroll
            for (int o = 1; o < 64; o <<= 1) { mq = __builtin_fmaxf(mq, __shfl_xor(mq, o)); mk = __builtin_fmaxf(mk, __shfl_xor(mk, o)); }
            const float lam_init = 0.8f - 0.6f * __expf(-0.3f * (float)l);
            if (lane == 0) { scal[l * 8 + 0] = __expf(s1) - __expf(s2) + lam_init; scal[l * 8 + 1] = 8.0f * mq * mk * LOG2E; scal[l * 8 + 2] = 1.0f - lam_init; }
        }
        for (int i = gw * 64 + lane; i < DB * NH * 2 * (4096 / 8); i += NGW * 64) { const int img = i / 512, ch = i % 512; *(u32x4*)(KTS + ((size_t)img * NTS + NTS - 1) * 4096 + ch * 8) = (u32x4){0u, 0u, 0u, 0u}; }
        for (int i = gw * 64 + lane; i < DB * NH * (8192 / 8); i += NGW * 64) { const int img = i / 1024, ch = i % 1024; *(u32x4*)(VTS + ((size_t)img * NTS + NTS - 1) * 8192 + ch * 8) = (u32x4){0u, 0u, 0u, 0u}; }
        __syncthreads();
        for (int un = vcu; un < DEPTH * NG; un += G) tables_gen(lds, A, un / NG, un % NG, tid);
    }
#endif
    xcd_barrier(bar, wave0);

#if REP == 20
    for (int q_ = 0; q_ < 16; ++q_) xcd_barrier(bar, wave0);
#endif
#pragma unroll 1
    for (int l = 0; l < DEPTH; ++l) {
#if PH(1)
for (int rep_ = 0; rep_ < (l == 0 ? REPN(1) : 1); ++rep_)
        {
            PHASE_BEGIN
            float* out = A->out;
            pg8::Gemm g{WSP(bf16_t, WS_XB), WSP(bf16_t, WS_WIN) + (size_t)l * INC * D, D, D, D, 0, 0}; pg8::TileOrder S; S.init(MT / 256, INC / 256, 1, G, bx);
            EpiIn E{WSP(float, WS_SSQ), A->in[8] + l * HD, A->in[9] + l * HD, out + O_KP + (size_t)l * MP * D, out + O_VP + (size_t)l * MP * D, out + O_KS + (size_t)l * MS * D, out + O_VS + (size_t)l * MS * D,
                    WSP(bf16_t, WS_QB), WSP(bf16_t, WS_KTP), WSP(bf16_t, WS_VTP), WSP(bf16_t, WS_KTS), WSP(bf16_t, WS_VTS), WSP(bf16_t, WS_GA), WSP(bf16_t, WS_UX), WSP(bf16_t, WS_GS), WSP(bf16_t, WS_GL), WSP(float, WS_US)};
            pg8::gemm_phase(lds, g, S, E, tid);
        }
#endif
        xcd_barrier(bar, wave0);

#if PH(2)
        for (int rep_ = 0; rep_ < (l == 0 ? REPN(10) : 1); ++rep_)
        {
            PHASE_BEGIN
            const float* scal = WSP(float, WS_SCAL); float* out = A->out;
            AttnJob J; J.GA = WSP(bf16_t, WS_GA); J.OA = WSP(bf16_t, WS_OA); J.subg = A->in[14] + l * VD; J.lam = scal[l * 8 + 0]; J.shift2 = scal[l * 8 + 1]; J.outscale = scal[l * 8 + 2]; J.Q = WSP(bf16_t, WS_QB);
            BgJob B; B.KTP = WSP(bf16_t, WS_KTP); B.VTP = WSP(bf16_t, WS_VTP); B.okp = out + O_KP + (size_t)l * MP * D; B.ovp = out + O_VP + (size_t)l * MP * D;
            B.ck = A->in[2] + (size_t)l * DB * PAST * D; B.cv = A->in[3] + (size_t)l * DB * PAST * D; B.KTS = WSP(bf16_t, WS_KTS); B.VTS = WSP(bf16_t, WS_VTS);
            for (int it = vcu; it < 512; it += G) {
                const int bh = it >> 3, s = it & 7, b = bh >> 3, h = bh & 7;
                J.K = WSP(bf16_t, WS_KTP) + (size_t)(bh * 2) * (T / 64) * 4096; J.kmap = (T / 64) * 4096; J.V = WSP(bf16_t, WS_VTP) + (size_t)bh * (T / 64) * 8192; J.head = h; J.sample = 0;
#pragma unroll 1
                for (int k = 0; k < 2; ++k) { const int qb = k ? 15 - s : s; J.qrow0 = b * T + qb * 128; J.qpos0 = qb * 128; J.nt = 2 * qb + 2;
                    B.base = (unsigned)((it * 34 + (k ? 2 * s + 2 : 0)) * 512); attn_unit<true>(lds, J, tid, B); }
            }
            __syncthreads();
        }
#if PH(12)
        for (int rep_ = 0; rep_ < (l == 0 ? REPN(12) : 1); ++rep_)
        {
            PHASE_BEGIN
            pg8::Gemm g{WSP(bf16_t, WS_UX), WSP(bf16_t, WS_BT1) + (size_t)l * (NG + 1) * 128 * LC * GC, KX, LC * GC, LC * GC, (size_t)NPAIR * KX, (size_t)128 * LC * GC}; pg8::TileOrder S; S.init(2, 1, NG, 128, bx >= 128 ? bx - 128 : -1);
            EpiS1 E{WSP(float, WS_HF)};
            pg8::gemm_phase(lds, g, S, E, tid);
        }
#endif
#endif
        xcd_barrier(bar, wave0);

#if PH(3)
for (int rep_ = 0; rep_ < (l == 0 ? REPN(3) : 1); ++rep_)
        {
            PHASE_BEGIN
            float* out = A->out; float* HF = WSP(float, WS_HF); bf16_t* UX = WSP(bf16_t, WS_UX); bf16_t* YS = WSP(bf16_t, WS_YS); const float* US = WSP(float, WS_US);
            const float* a32t = WSP(float, WS_SCAL) + SC_A32 + (size_t)l * NG * SP * 2;
            const bool split = G > DB * NH; const int gw2 = split ? (bx - DB * NH) * NWAVES + wave : gw, NGW2 = split ? (G - DB * NH) * NWAVES : NGW;
            if (bx < DB * NH) {
                const float* scal = WSP(float, WS_SCAL);
                AttnJob J; J.GA = WSP(bf16_t, WS_GA); J.OA = WSP(bf16_t, WS_OA); J.subg = A->in[14] + l * VD; J.lam = scal[l * 8 + 0]; J.shift2 = scal[l * 8 + 1]; J.outscale = scal[l * 8 + 2]; J.Q = WSP(bf16_t, WS_QB);
                const int bh = bx, b = bh >> 3, h = bh & 7;
                J.K = WSP(bf16_t, WS_KTS) + (size_t)(bh * 2) * NTS * 4096; J.kmap = NTS * 4096; J.V = WSP(bf16_t, WS_VTS) + (size_t)bh * NTS * 8192; J.head = h; J.sample = 1;
                J.qrow0 = MP + b * DS; J.qpos0 = PAST; J.nt = NTS; BgJob B{}; attn_unit<false>(lds, J, tid, B);
                __syncthreads();
            }
            if (!split || bx >= DB * NH) {
            for (int it = gw2; it < NB * NG; it += NGW2) {
                const int b = it >> 6, g = it & 63, p = lane; const float ar = a32t[(g * SP + p) * 2], ai = a32t[(g * SP + p) * 2 + 1];
                const float* hf = HF + ((size_t)g * NPAIR + b * 64) * 128; bf16_t* ux = UX + ((size_t)g * NPAIR + b * 64) * KX + LC * GC;
                float hr = 0.f, hi_ = 0.f;
#pragma unroll 1
                for (int c0 = 0; c0 < 64; c0 += 16) { float fr_[16], fi_[16];
#pragma unroll
                    for (int c = 0; c < 16; ++c) { fr_[c] = hf[(size_t)(c0 + c) * 128 + p]; fi_[c] = hf[(size_t)(c0 + c) * 128 + 64 + p]; }
#pragma unroll
                    for (int c = 0; c < 16; ++c) { ux[(size_t)(c0 + c) * KX + p] = f2bf(hr); ux[(size_t)(c0 + c) * KX + 64 + p] = f2bf(hi_);
                        const float nr = ar * hr - ai * hi_ + fr_[c], ni = ar * hi_ + ai * hr + fi_[c]; hr = nr; hi_ = ni; } }
                out[O_HRP + ((size_t)(l * NB + b) * NG + g) * SP + p] = hr; out[O_HIP + ((size_t)(l * NB + b) * NG + g) * SP + p] = hi_;
            }
            LAS float* hs = (LAS float*)(lds + wave * 8192);
            for (int it = gw2; it < DB * NG; it += NGW2) {
                const int b = it >> 6, g = it & 63, p = lane;
                const float lr = A->in[16][(size_t)(l * NG + g) * SP + p], li = A->in[17][(size_t)(l * NG + g) * SP + p], dt = __expf(A->in[18][l * NG + g]);
                const float mg = __expf(lr * dt); float tr = li * dt * 0.15915494309189535f; tr -= rintf(tr);
                const float ar = mg * __builtin_amdgcn_cosf(tr), ai = mg * __builtin_amdgcn_sinf(tr), zr = ar - 1.0f, zi = ai, den = lr * lr + li * li;
                const float wre = (zr * lr + zi * li) / den, wim = (zi * lr - zr * li) / den;
                float bbr[GC], bbi[GC];
#pragma unroll
                for (int n = 0; n < GC; ++n) { const float br = A->in[19][((size_t)(l * NG + g) * SP + p) * GC + n], bi = A->in[20][((size_t)(l * NG + g) * SP + p) * GC + n]; bbr[n] = wre * br - wim * bi; bbi[n] = wre * bi + wim * br; }
                float hr = A->in[4][((size_t)(l * DB + b) * NG + g) * SP + p], hi_ = A->in[5][((size_t)(l * DB + b) * NG + g) * SP + p];
                const float* ub = US + (size_t)(b * DS) * D + g * GC;
#pragma unroll 1
                for (int t = 0; t < DS; ++t) { float bur = 0.f, bui = 0.f;
#pragma unroll
                    for (int n = 0; n < GC; ++n) { const float uv = ub[(size_t)t * D + n]; bur += uv * bbr[n]; bui += uv * bbi[n]; }
                    const float nr = ar * hr - ai * hi_ + bur, ni = ar * hi_ + ai * hr + bui; hr = nr; hi_ = ni;
                    hs[(t * 64 + p) * 2] = hr; hs[(t * 64 + p) * 2 + 1] = hi_; }
                out[O_HRS + ((size_t)(l * DB + b) * NG + g) * SP + p] = hr; out[O_HIS + ((size_t)(l * DB + b) * NG + g) * SP + p] = hi_;
                LDS_WAIT(); asm volatile("" ::: "memory");
                const int t = lane >> 2, n4 = (lane & 3) * 4; float y[4] = {0.f, 0.f, 0.f, 0.f};
                const float* cr = A->in[21] + ((size_t)(l * NG + g) * GC + n4) * SP; const float* ci = A->in[22] + ((size_t)(l * NG + g) * GC + n4) * SP;
                for (int q = 0; q < SP; ++q) { const float xr = hs[(t * 64 + q) * 2], xi = hs[(t * 64 + q) * 2 + 1];
#pragma unroll
                    for (int k = 0; k < 4; ++k) y[k] += xr * cr[k * SP + q] - xi * ci[k * SP + q]; }
                u32x2 w; float yv[4];
#pragma unroll
                for (int k = 0; k < 4; ++k) yv[k] = geluf_(y[k] + A->in[23][l * D + g * GC + n4 + k] * ub[(size_t)t * D + n4 + k]);
                w.x = pk2bf(yv[0], yv[1]); w.y = pk2bf(yv[2], yv[3]);
                *(u32x2*)(YS + (size_t)(MP + b * DS + t) * D + g * GC + n4) = w;
                LDS_WAIT(); asm volatile("" ::: "memory");
            }
            __syncthreads();
            { const int c2 = split ? bx - DB * NH : vcu, G2 = split ? G - DB * NH : G;
              for (int un = c2; un < NG * 4; un += G2) tables_expand(lds, A, l, un, tid); }
            }
        }
#endif
        xcd_barrier(bar, wave0);

#if PH(4)
#if PH(13)
for (int rep_ = 0; rep_ < (l == 0 ? REPN(13) : 1); ++rep_)
        { PHASE_BEGIN
          pg8::Gemm g{WSP(bf16_t, WS_UX), WSP(bf16_t, WS_BT2), KX, KX, KX, (size_t)NPAIR * KX, (size_t)(LC * GC) * KX}; pg8::TileOrder S; S.init(2, 2, NG, G, bx);
          EpiS2 E{WSP(bf16_t, WS_YS)}; pg8::gemm_phase(lds, g, S, E, tid); }
#endif
        __syncthreads();
#if PH(14)
for (int rep_ = 0; rep_ < (l == 0 ? REPN(14) : 1); ++rep_)
        { PHASE_BEGIN
          pg8::Gemm g{WSP(bf16_t, WS_OA), WSP(bf16_t, WS_WSM) + (size_t)(l * 4 + 0) * D * D, D, D, D, 0, 0}; pg8::TileOrder S; S.init(MT / 256, D / 256, 1, G, bx);
          EpiAP E{WSP(bf16_t, WS_GL), WSP(bf16_t, WS_MGA)}; pg8::gemm_phase(lds, g, S, E, tid); }
#endif
#endif
        xcd_barrier(bar, wave0);
#if PH(5)
for (int rep_ = 0; rep_ < (l == 0 ? REPN(5) : 1); ++rep_)
        { PHASE_BEGIN
          pg8::Gemm g{WSP(bf16_t, WS_YS), WSP(bf16_t, WS_WSM) + (size_t)(l * 4 + 1) * D * D, D, D, D, 0, 0}; pg8::TileOrder S; S.init(MT / 256, D / 256, 1, G, bx);
          EpiGLU E{WSP(bf16_t, WS_YS), WSP(bf16_t, WS_GS), A->in[25] + l * D, WSP(bf16_t, WS_Z)}; pg8::gemm_phase(lds, g, S, E, tid); }
#endif
        xcd_barrier(bar, wave0);
#if PH(6)
for (int rep_ = 0; rep_ < (l == 0 ? REPN(6) : 1); ++rep_)
        { PHASE_BEGIN
          pg8::Gemm g{WSP(bf16_t, WS_Z), WSP(bf16_t, WS_WSM) + (size_t)(l * 4 + 2) * D * D, D, D, D, 0, 0}; pg8::TileOrder S; S.init(MT / 256, D / 256, 1, G, bx);
          EpiSP E{WSP(bf16_t, WS_GL), WSP(bf16_t, WS_MGA), WSP(bf16_t, WS_MG)}; pg8::gemm_phase(lds, g, S, E, tid); }
#endif
        xcd_barrier(bar, wave0);
#if PH(7)
for (int rep_ = 0; rep_ < (l == 0 ? REPN(7) : 1); ++rep_)
        { PHASE_BEGIN
          float* out = A->out;
          pg8::Gemm g{WSP(bf16_t, WS_MG), WSP(bf16_t, WS_WSM) + (size_t)(l * 4 + 3) * D * D, D, D, D, 0, 0}; pg8::TileOrder S; S.init(MT / 256, D / 256, 1, G, bx);
          EpiOut E{WSP(bf16_t, WS_XB), out + O_Y, WSP(float, WS_SSQ), l + 1 < DEPTH ? 1 : 0}; pg8::gemm_phase(lds, g, S, E, tid); }
#endif
        if (l + 1 < DEPTH) xcd_barrier(bar, wave0);
    }
}

extern "C" void kernel_launch(void* const* d_in, const int* in_sizes, int n_in, void* d_out, int out_size, void* d_ws, size_t ws_size, hipStream_t stream) {
    static int grid = 0;
    if (grid == 0) {
        if (n_in != 28 || out_size != (int)O_END || ws_size < WS_END) { fprintf(stderr, "kernel_launch: unexpected problem (n_in %d, out %d, ws %zu)\n", n_in, out_size, ws_size); grid = -1; return; }
        int dev = 0, cus = 0, per_cu = 0;
        if (hipGetDevice(&dev) != hipSuccess || hipDeviceGetAttribute(&cus, hipDeviceAttributeMultiprocessorCount, dev) != hipSuccess) { grid = -1; return; }
        if (hipFuncSetAttribute((const void*)mega_fwd, hipFuncAttributeMaxDynamicSharedMemorySize, LDS_BYTES) != hipSuccess) { fprintf(stderr, "kernel_launch: hipFuncSetAttribute failed\n"); grid = -1; return; }
        if (hipOccupancyMaxActiveBlocksPerMultiprocessor(&per_cu, (const void*)mega_fwd, NTHREADS, LDS_BYTES) != hipSuccess || per_cu < 1) { fprintf(stderr, "kernel_launch: occupancy query reports %d\n", per_cu); }
        (void)hipGetLastError();
        grid = cus;
    }
    if (grid < 0) return;
    (void)hipMemsetAsync((char*)d_ws + WS_CTL, 0, CTL_ZERO_BYTES, stream);
    Args a{};
    for (int i = 0; i < 28; ++i) a.in[i] = (const float*)d_in[i];
    a.out = (float*)d_out; a.ws = (unsigned char*)d_ws;
    hipLaunchKernelGGL(mega_fwd, dim3(grid), dim3(NTHREADS), LDS_BYTES, stream, a);
}
```

```cpp
#include <hip/hip_runtime.h>
#include <cstdio>
#include <cstdint>

#define LAS __attribute__((address_space(3)))
#define GAS __attribute__((address_space(1)))
typedef unsigned short bf16_t;
typedef short bf16x8 __attribute__((ext_vector_type(8)));
typedef short s16x4 __attribute__((ext_vector_type(4)));
typedef float f32x2 __attribute__((ext_vector_type(2)));
typedef float f32x4 __attribute__((ext_vector_type(4)));
typedef float f32x16 __attribute__((ext_vector_type(16)));
typedef unsigned u32x2 __attribute__((ext_vector_type(2)));
typedef unsigned u32x4 __attribute__((ext_vector_type(4)));

constexpr int D = 1024, NB = 8, T = 2048, DEPTH = 2, DB = 16, DS = 16, PAST = 1024, NH = 8, HD = 64, VD = 128;
constexpr int MP = NB * T, MS = DB * DS, MT = MP + MS, INC = 8192;
constexpr int NG = 64, GC = 16, SP = 64, LC = 32, NPAIR = MP / LC;
constexpr int KX = LC * GC + 2 * SP;
constexpr float EPS = 1e-6f, LOG2E = 1.4426950408889634f;
constexpr int NTS = PAST / 64 + 1;
constexpr size_t O_Y = 0, O_KP = 17039360, O_VP = 50593792, O_HRP = 84148224, O_HIP = 84213760, O_KS = 84279296, O_VS = 84803584, O_HRS = 85327872, O_HIS = 85458944, O_END = 85590016;
constexpr size_t MiB = 1u << 20;
constexpr size_t WS_CTL = 0, CTL_ZERO_BYTES = 64 * 1024, WS_SCAL = 1 * MiB, WS_WIN = 2 * MiB, WS_WSM = 34 * MiB, WS_BT2 = 50 * MiB, WS_BT1 = 90 * MiB  ,
                 WS_XB = 108 * MiB, WS_QB = 141 * MiB  , WS_KTP = 174 * MiB  , WS_VTP = 207 * MiB  , WS_KTS = 240 * MiB, WS_VTS = 274 * MiB,
                 WS_GA = 308 * MiB  , WS_GS = 341 * MiB, WS_GL = 374 * MiB, WS_UX = 439 * MiB, WS_HF = 479 * MiB, WS_SSQ = 495 * MiB, WS_US = 497 * MiB, WS_KCG = 498 * MiB, WS_END = 502 * MiB;
constexpr size_t WS_OA = WS_QB, WS_MG = WS_QB, WS_YS = WS_KTP, WS_MGA = WS_VTP, WS_Z = WS_GA;
constexpr int SC_A32 = 1024;

__device__ __forceinline__ unsigned pk2bf(float lo, float hi) { typedef __bf16 b2 __attribute__((ext_vector_type(2))); f32x2 v = {lo, hi}; b2 b = __builtin_convertvector(v, b2); return __builtin_bit_cast(unsigned, b); }
__device__ __forceinline__ u32x4 pk8bf(const float* v) { u32x4 w; w.x = pk2bf(v[0], v[1]); w.y = pk2bf(v[2], v[3]); w.z = pk2bf(v[4], v[5]); w.w = pk2bf(v[6], v[7]); return w; }
__device__ __forceinline__ void unpk8bf(u32x4 w, float* v) {
    v[0] = __uint_as_float(w.x << 16); v[1] = __uint_as_float(w.x & 0xffff0000u); v[2] = __uint_as_float(w.y << 16); v[3] = __uint_as_float(w.y & 0xffff0000u);
    v[4] = __uint_as_float(w.z << 16); v[5] = __uint_as_float(w.z & 0xffff0000u); v[6] = __uint_as_float(w.w << 16); v[7] = __uint_as_float(w.w & 0xffff0000u); }
__device__ __forceinline__ float bf2f(bf16_t x) { return __uint_as_float((unsigned)x << 16); }
__device__ __forceinline__ bf16_t f2bf(float f) { return (bf16_t)(pk2bf(f, 0.f) & 0xffffu); }
__device__ __forceinline__ float sigmoidf_(float x) { return __builtin_amdgcn_rcpf(1.0f + __builtin_amdgcn_exp2f(-LOG2E * x)); }
__device__ __forceinline__ float siluf_(float x) { return x * sigmoidf_(x); }
__device__ __forceinline__ float geluf_(float x) { return x * sigmoidf_(1.5957691216057308f * (x + 0.044715f * x * x * x)); }
__device__ __forceinline__ int lane_id() { int l; asm volatile("v_mbcnt_lo_u32_b32 %0, -1, 0\n\tv_mbcnt_hi_u32_b32 %0, -1, %0" : "=v"(l)); return l; }
#define LDS_WAIT() asm volatile("s_waitcnt lgkmcnt(0)" ::: "memory")
#define VM_WAIT() asm volatile("s_waitcnt vmcnt(0)" ::: "memory")

namespace pg8 {
constexpr int BM = 256, BK = 64, HALF = 128, HTB = HALF * BK * 2, STAGE_BYTES = 8 * HTB, NXCD = 8, WGM = 8;
__device__ __forceinline__ int lds_byte(int r, int c) { const int st = (r >> 4) * 2 + (c >> 5), rr = r & 15, cc = c & 31, ob = rr * 64 + cc * 2; return st * 1024 + (ob ^ (((ob >> 9) & 1) << 5)); }
__device__ __forceinline__ void stage_rc(int b, int& R, int& C) { const int st = b / 1024, sb = b % 1024, swz = sb ^ (((sb >> 9) & 1) << 5); R = (st >> 1) * 16 + swz / 64; C = (st & 1) * 32 + (swz % 64) / 2; }
__device__ __forceinline__ int perm32(int rho) { const int n = rho >> 4, i = rho & 15; return 8 * (i >> 2) + 4 * n + (i & 3); }

struct Unit { int pm, pn, grp; };
struct Gemm { const bf16_t* A; const bf16_t* Bt; int lda, ldb, K; size_t gsA, gsB; };

struct TileOrder {
    int nM, nN, per, total, G, c;
    __device__ void init(int nM_, int nN_, int nG_, int G_, int c_) { nM = nM_; nN = nN_; per = nM_ * nN_; total = per * nG_; G = G_; c = c_; }
    __device__ bool next(int i, Unit& u) const {
        if (c < 0) return false;
        const long L = (long)i * G + c; if (L >= total) return false;
        map((int)L, u); return true;
    }
    __device__ void map(int L, Unit& u) const {
        int wgid = L; { const int q = total / NXCD, r = total % NXCD, xcd = wgid % NXCD, off = wgid / NXCD; wgid = (xcd < r ? xcd * (q + 1) : r * (q + 1) + (xcd - r) * q) + off; }
        u.grp = wgid / per; const int rem = wgid % per;
        const int nig = WGM * nN, gid = rem / nig, fm = gid * WGM, gsz = (nM - fm) < WGM ? (nM - fm) : WGM;
        u.pm = fm + ((rem % nig) % gsz); u.pn = (rem % nig) / gsz;
    }
};
struct OneUnit { Unit u; __device__ bool next(int i, Unit& o) const { if (i != 0) return false; o = u; return true; } };

template <class Epi, class Sched>
__device__ __forceinline__ void gemm_phase(LAS unsigned char* lds, const Gemm g, const Sched& S, const Epi& E, int tid) {
    const int wid = __builtin_amdgcn_readfirstlane(tid >> 6), lane = tid & 63, wr = wid >> 2, wc = wid & 3, fr = lane & 15, fq = lane >> 4;
    const int nt = g.K / BK;
    unsigned voffA[2], voffB[2];
#pragma unroll
    for (int i = 0; i < 2; ++i) { int R, C; stage_rc(tid * 16 + i * 8192, R, C); const int Rb = (R & ~31) + perm32(R & 31);
        voffA[i] = (unsigned)(R * g.lda + C) * 2u; voffB[i] = (unsigned)(Rb * g.ldb + C) * 2u; }
    const size_t kstep = (size_t)(BK * 2);
    const size_t hstepA = (size_t)HALF * g.lda * 2, hstepB = (size_t)HALF * g.ldb * 2;
    const unsigned ldsw = (unsigned)wid * 1024u;
    const int aoff = lds_byte(wr * 64 + fr, fq * 8), boff = lds_byte(wc * 32 + fr, fq * 8);
#define PG8_SA(b, h) (((b) * 2 + (h)) * HTB)
#define PG8_SB(b, h) ((4 + (b) * 2 + (h)) * HTB)
#define PG8_STAGE(bufoff, gbase, voff) do { _Pragma("unroll") for (int _i = 0; _i < 2; ++_i) \
        __builtin_amdgcn_global_load_lds((const unsigned*)((const char*)(gbase) + (voff)[_i]), (LAS unsigned*)(lds + (bufoff) + ldsw + _i * 8192), 16, 0, 0); } while (0)
#define PG8_LDA(dst, b, h) do { _Pragma("unroll") for (int m = 0; m < 4; ++m) _Pragma("unroll") for (int k = 0; k < 2; ++k) dst[m][k] = *(const LAS bf16x8*)(lds + PG8_SA(b, h) + aoff + m * 2048 + k * 1024); } while (0)
#define PG8_LDB(dst, b, h) do { _Pragma("unroll") for (int n = 0; n < 2; ++n) _Pragma("unroll") for (int k = 0; k < 2; ++k) dst[n][k] = *(const LAS bf16x8*)(lds + PG8_SB(b, h) + boff + n * 2048 + k * 1024); } while (0)
#define PG8_MMA(ai, bj, At, Bt) do { __builtin_amdgcn_s_setprio(1); _Pragma("unroll") for (int m = 0; m < 4; ++m) _Pragma("unroll") for (int n = 0; n < 2; ++n) _Pragma("unroll") for (int k = 0; k < 2; ++k) \
        acc[ai][bj][m][n] = __builtin_amdgcn_mfma_f32_16x16x32_bf16(Bt[n][k], At[m][k], acc[ai][bj][m][n], 0, 0, 0); __builtin_amdgcn_s_setprio(0); } while (0)
#define PG8_WAIT_V(n) asm volatile("s_waitcnt vmcnt(" #n ")" ::: "memory")
#define PG8_WAIT_L(n) asm volatile("s_waitcnt lgkmcnt(" #n ")" ::: "memory")
#define PG8_BAR __builtin_amdgcn_s_barrier()
#define PG8_SCHED __builtin_amdgcn_sched_barrier(0)
#define PG8_ABASE(u) ((const char*)g.A + ((size_t)(u).grp * g.gsA + (size_t)(u).pm * BM * g.lda) * 2)
#define PG8_BBASE(u) ((const char*)g.Bt + ((size_t)(u).grp * g.gsB + (size_t)(u).pn * BM * g.ldb) * 2)
    Unit cur, nxt; int ui = 0;
    if (!S.next(0, cur)) return;
    f32x4 acc[2][2][4][2];
#pragma unroll
    for (int a = 0; a < 2; ++a)
#pragma unroll
        for (int b = 0; b < 2; ++b)
#pragma unroll
            for (int m = 0; m < 4; ++m)
#pragma unroll
                for (int n = 0; n < 2; ++n) acc[a][b][m][n] = (f32x4){0.f, 0.f, 0.f, 0.f};
    bf16x8 At[4][2], B0[2][2], B1[2][2];
    const char* cA = PG8_ABASE(cur); const char* cB = PG8_BBASE(cur);
    PG8_STAGE(PG8_SB(0, 0), cB, voffB); PG8_STAGE(PG8_SB(0, 1), cB + hstepB, voffB); PG8_STAGE(PG8_SA(0, 0), cA, voffA); PG8_STAGE(PG8_SA(0, 1), cA + hstepA, voffA);
    if (wr == 1) PG8_BAR;
    PG8_WAIT_V(2); PG8_BAR;
    PG8_STAGE(PG8_SB(1, 0), cB + kstep, voffB); PG8_STAGE(PG8_SA(1, 0), cA + kstep, voffA); PG8_STAGE(PG8_SB(1, 1), cB + hstepB + kstep, voffB);
    PG8_WAIT_V(6); PG8_BAR;
    for (;;) {
        const bool has_next = S.next(ui + 1, nxt);
        const char* nA = has_next ? PG8_ABASE(nxt) : cA; const char* nB = has_next ? PG8_BBASE(nxt) : cB;
        for (int t = 0; t < nt; t += 2) {
            const bool last = (t == nt - 2);
            const char* a1 = cA + (size_t)(t + 1) * kstep;
            const char* a2 = last ? nA : cA + (size_t)(t + 2) * kstep; const char* b2 = last ? nB : cB + (size_t)(t + 2) * kstep;
            const char* a3 = a2 + kstep; const char* b3 = b2 + kstep;
            PG8_LDB(B0, 0, 0); PG8_LDB(B1, 0, 1); PG8_SCHED; PG8_LDA(At, 0, 0); PG8_STAGE(PG8_SA(1, 1), a1 + hstepA, voffA);
            PG8_WAIT_V(8); PG8_WAIT_L(0); PG8_BAR; PG8_MMA(0, 0, At, B0); PG8_MMA(0, 1, At, B1); PG8_BAR; PG8_SCHED;
            PG8_LDA(At, 0, 1); PG8_STAGE(PG8_SB(0, 0), b2, voffB); PG8_STAGE(PG8_SB(0, 1), b2 + hstepB, voffB); PG8_STAGE(PG8_SA(0, 0), a2, voffA);
            PG8_WAIT_V(8); PG8_WAIT_L(0); PG8_BAR; PG8_MMA(1, 0, At, B0); PG8_MMA(1, 1, At, B1); PG8_BAR; PG8_SCHED;
            PG8_LDB(B0, 1, 0); PG8_LDB(B1, 1, 1); PG8_SCHED; PG8_LDA(At, 1, 0); PG8_STAGE(PG8_SA(0, 1), a2 + hstepA, voffA);
            PG8_WAIT_V(8); PG8_WAIT_L(0); PG8_BAR; PG8_MMA(0, 0, At, B0); PG8_MMA(0, 1, At, B1); PG8_BAR; PG8_SCHED;
            PG8_LDA(At, 1, 1); PG8_STAGE(PG8_SB(1, 0), b3, voffB); PG8_STAGE(PG8_SB(1, 1), b3 + hstepB, voffB); PG8_STAGE(PG8_SA(1, 0), a3, voffA);
            PG8_WAIT_V(8); PG8_WAIT_L(0); PG8_BAR; PG8_MMA(1, 0, At, B0); PG8_MMA(1, 1, At, B1); PG8_BAR; PG8_SCHED;
        }
        if (wr == 0) PG8_BAR;
        E(acc, cur, wr, wc, fr, fq);
        if (!has_next) break;
#pragma unroll
        for (int a = 0; a < 2; ++a)
#pragma unroll
            for (int b = 0; b < 2; ++b)
#pragma unroll
                for (int m = 0; m < 4; ++m)
#pragma unroll
                    for (int n = 0; n < 2; ++n) acc[a][b][m][n] = (f32x4){0.f, 0.f, 0.f, 0.f};
        cur = nxt; cA = nA; cB = nB; ++ui;
        if (wr == 1) PG8_BAR;
    }
    PG8_WAIT_V(0);
    PG8_BAR;
#undef PG8_SA
#undef PG8_SB
#undef PG8_STAGE
#undef PG8_LDA
#undef PG8_LDB
#undef PG8_MMA
#undef PG8_WAIT_V
#undef PG8_WAIT_L
#undef PG8_BAR
#undef PG8_SCHED
#undef PG8_ABASE
#undef PG8_BBASE
}
}
using pg8::Unit;

#define EPI_ROWX(ai, m) (u.pm * 256 + (ai) * 128 + wr * 64 + (m) * 16 + fr)
#define EPI_FOR_M _Pragma("unroll") for (int m = 0; m < 4; ++m)
#define EPI_FOR_BJ _Pragma("unroll") for (int bj = 0; bj < 2; ++bj)
#define EPI_GET8(v, bj) float v[8] = {acc[ai][bj][m][0][0], acc[ai][bj][m][0][1], acc[ai][bj][m][0][2], acc[ai][bj][m][0][3], acc[ai][bj][m][1][0], acc[ai][bj][m][1][1], acc[ai][bj][m][1][2], acc[ai][bj][m][1][3]}
#define EPI_FENCE __builtin_amdgcn_sched_barrier(0)
typedef const f32x4 (&AccRef)[2][2][4][2];
__device__ __forceinline__ void st8f(float* b, unsigned o, const float* v) { GAS f32x4* p = (GAS f32x4*)((GAS float*)b + o); p[0] = (f32x4){v[0], v[1], v[2], v[3]}; p[1] = (f32x4){v[4], v[5], v[6], v[7]}; }
__device__ __forceinline__ void ld8f(const float* b, unsigned o, float* v) { const GAS f32x4* p = (const GAS f32x4*)((const GAS float*)b + o); const f32x4 a = p[0], c = p[1]; v[0] = a[0]; v[1] = a[1]; v[2] = a[2]; v[3] = a[3]; v[4] = c[0]; v[5] = c[1]; v[6] = c[2]; v[7] = c[3]; }
__device__ __forceinline__ u32x4 ld8raw(const bf16_t* b, unsigned o) { return *(const GAS u32x4*)((const GAS bf16_t*)b + o); }
__device__ __forceinline__ void st8b(bf16_t* b, unsigned o, const float* v) { *(GAS u32x4*)((GAS bf16_t*)b + o) = pk8bf(v); }
__device__ __forceinline__ void st8b_wt(bf16_t* b, unsigned o, const float* v) { const u32x4 w = pk8bf(v); GAS bf16_t* p = (GAS bf16_t*)b + o; asm volatile("global_store_dwordx4 %0, %1, off sc1\n\ts_nop 1" :: "v"(p), "v"(w) : "memory"); }

struct EpiIn {
    const float* ssq; const float* qg; const float* kg;
    float *okp, *ovp, *oks, *ovs;
    bf16_t *QB, *KTP, *VTP, *KTS, *VTS, *GA, *UX, *GS, *GL; float* US;
    __device__ __forceinline__ void operator()(AccRef acc, const Unit& u, int wr, int wc, int fr, int fq) const {
        const int pn = u.pn; const bool smp = (u.pm == MP / 256);
        float rinv[2][4];
        { f32x4 t[2][4];
#pragma unroll
          for (int ai = 0; ai < 2; ++ai) EPI_FOR_M t[ai][m] = *(const GAS f32x4*)((const GAS float*)ssq + (unsigned)(EPI_ROWX(ai, m) * 16 + 4 * fq));
#pragma unroll
          for (int ai = 0; ai < 2; ++ai) EPI_FOR_M { float x = (t[ai][m][0] + t[ai][m][1]) + (t[ai][m][2] + t[ai][m][3]); x += __shfl_xor(x, 16); x += __shfl_xor(x, 32); rinv[ai][m] = __builtin_amdgcn_rsqf(x * (1.0f / D) + EPS); } }
        if (pn < 8) {
            const bool isk = pn >= 4; const float* g = isk ? kg : qg; const float scale = isk ? 1.0f : 0.125f * LOG2E;
            float gv[2][8];
            EPI_FOR_BJ ld8f(g, 32 * bj + 8 * fq, gv[bj]);
            const int ct = (isk ? pn - 4 : pn) * 256 + 64 * wc + 8 * fq;
            const int mapi = ct >> 9, head = (ct >> 6) & 7;
#pragma unroll
            for (int ai = 0; ai < 2; ++ai) EPI_FOR_M { EPI_FENCE; const int row = EPI_ROWX(ai, m); const float ri = rinv[ai][m];
                EPI_GET8(v0, 0); EPI_GET8(v1, 1); float s = 0.f;
#pragma unroll
                for (int j = 0; j < 8; ++j) { v0[j] *= ri; v1[j] *= ri; s += v0[j] * v0[j] + v1[j] * v1[j]; }
                s += __shfl_xor(s, 16); s += __shfl_xor(s, 32);
                const float rn = __builtin_amdgcn_rsqf(s * (1.0f / HD) + EPS) * scale;
#pragma unroll
                for (int j = 0; j < 8; ++j) { v0[j] *= rn * gv[0][j]; v1[j] *= rn * gv[1][j]; }
                if (!isk) { const unsigned qo = (unsigned)(row * D + head * 128 + mapi * 64 + 8 * fq); st8b(QB, qo, v0); st8b(QB, qo + 32, v1); }
                else {
                    if (smp) { const unsigned oo = (unsigned)((row - MP) * D + ct); st8f(oks, oo, v0); st8f(oks, oo + 32, v1); }
                    bf16_t* img; unsigned io; int kv;
                    if (smp) { const int rs = row - MP, b = rs >> 4; kv = rs & 15; img = KTS; io = (unsigned)((((b * NH + head) * 2 + mapi) * NTS + (NTS - 1)) * 4096); }
                    else { const int b = row >> 11, t = row & (T - 1); kv = t & 63; img = KTP; io = (unsigned)((((b * NH + head) * 2 + mapi) * (T / 64) + (t >> 6)) * 4096); }
                    io += (fq >> 1) * 1024 + (fq & 1) * 512 + kv * 8; st8b(img, io, v0); st8b(img, io + 2048, v1);
                }
            }
        } else if (pn < 12) {
#pragma unroll
            for (int ai = 0; ai < 2; ++ai) EPI_FOR_M { EPI_FENCE; const int row = EPI_ROWX(ai, m); const float ri = rinv[ai][m];
                EPI_FOR_BJ { EPI_GET8(v, bj);
#pragma unroll
                    for (int j = 0; j < 8; ++j) v[j] *= ri;
                    const int ct = (pn - 8) * 256 + 128 * bj + 32 * wc + 8 * fq, head = ct >> 7;
                    if (smp) st8f(ovs, (unsigned)((row - MP) * D + ct), v);
                    bf16_t* img; unsigned io; int kv;
                    if (smp) { const int rs = row - MP, b = rs >> 4; kv = rs & 15; img = VTS; io = (unsigned)(((b * NH + head) * NTS + (NTS - 1)) * 8192); }
                    else { const int b = row >> 11, t = row & (T - 1); kv = t & 63; img = VTP; io = (unsigned)(((b * NH + head) * (T / 64) + (t >> 6)) * 8192); }
                    st8b(img, io + wc * 2048 + (kv >> 4) * 512 + (kv & 15) * 32 + 8 * fq, v); } }
        } else if (pn < 16 || (pn >= 20 && pn < 24)) {
            bf16_t* dst = pn < 16 ? GA : GS; const int c0 = (pn < 16 ? pn - 12 : pn - 20) * 256 + 32 * wc + 8 * fq;
#pragma unroll
            for (int ai = 0; ai < 2; ++ai) EPI_FOR_M { EPI_FENCE; const int row = EPI_ROWX(ai, m); const float ri = rinv[ai][m];
                EPI_FOR_BJ { EPI_GET8(v, bj);
#pragma unroll
                    for (int j = 0; j < 8; ++j) v[j] = siluf_(v[j] * ri);
                    st8b(dst, (unsigned)(row * D + c0 + 128 * bj), v); } }
        } else if (pn < 20) {
#pragma unroll
            for (int ai = 0; ai < 2; ++ai) EPI_FOR_M { EPI_FENCE; const int row = EPI_ROWX(ai, m); const float ri = rinv[ai][m];
                EPI_FOR_BJ { EPI_GET8(v, bj);
#pragma unroll
                    for (int j = 0; j < 8; ++j) v[j] *= ri;
                    const int ct = (pn - 16) * 256 + 128 * bj + 32 * wc + 8 * fq;
                    if (smp) st8f(US, (unsigned)((row - MP) * D + ct), v);
                    else st8b(UX, (unsigned)(((ct >> 4) * NPAIR + (row >> 5)) * KX + (row & 31) * GC + (ct & 15)), v); } }
        } else {
            const int c0 = (pn - 24) * 256 + 32 * wc + 8 * fq;
#pragma unroll
            for (int ai = 0; ai < 2; ++ai) EPI_FOR_M { EPI_FENCE; const int row = EPI_ROWX(ai, m); const float ri = rinv[ai][m];
                EPI_FOR_BJ { EPI_GET8(v, bj);
#pragma unroll
                    for (int j = 0; j < 8; ++j) v[j] = sigmoidf_(v[j] * ri);
                    st8b(GL, (unsigned)(row * 2048 + c0 + 128 * bj), v); } }
        }
    }
};
struct EpiS1 { float* HF;
    __device__ __forceinline__ void operator()(AccRef acc, const Unit& u, int wr, int wc, int fr, int fq) const {
#pragma unroll
        for (int ai = 0; ai < 2; ++ai) EPI_FOR_M { const int row = EPI_ROWX(ai, m); EPI_GET8(v, 0); st8f(HF, (unsigned)((u.grp * NPAIR + row) * 128 + 32 * wc + 8 * fq), v); } } };
struct EpiS2 { bf16_t* YS;
    __device__ __forceinline__ void operator()(AccRef acc, const Unit& u, int wr, int wc, int fr, int fq) const {
#pragma unroll
        for (int ai = 0; ai < 2; ++ai) EPI_FOR_M { EPI_FENCE; const int pair = EPI_ROWX(ai, m);
            EPI_FOR_BJ { EPI_GET8(v, bj);
#pragma unroll
                for (int j = 0; j < 8; ++j) v[j] = geluf_(v[j]);
                const int col = u.pn * 256 + 128 * bj + 32 * wc + 8 * fq, jt = col >> 4, no = col & 15;
                st8b(YS, (unsigned)((pair * LC + jt) * D + u.grp * GC + no), v); } } } };
struct EpiAP { const bf16_t* GL; bf16_t* MGA;
    __device__ __forceinline__ void operator()(AccRef acc, const Unit& u, int wr, int wc, int fr, int fq) const {
        const int c0 = u.pn * 256 + 32 * wc + 8 * fq;
        u32x4 gr[2][4][2];
#pragma unroll
        for (int ai = 0; ai < 2; ++ai) EPI_FOR_M EPI_FOR_BJ gr[ai][m][bj] = ld8raw(GL, (unsigned)(EPI_ROWX(ai, m) * 2048 + c0 + 128 * bj));
#pragma unroll
        for (int ai = 0; ai < 2; ++ai) EPI_FOR_M { EPI_FENCE; const int row = EPI_ROWX(ai, m);
            EPI_FOR_BJ { EPI_GET8(v, bj); float g[8]; unpk8bf(gr[ai][m][bj], g);
#pragma unroll
                for (int j = 0; j < 8; ++j) v[j] *= g[j];
                st8b_wt(MGA, (unsigned)(row * D + c0 + 128 * bj), v); } } } };
struct EpiGLU { const bf16_t* YS; const bf16_t* GS; const float* bias; bf16_t* Z;
    __device__ __forceinline__ void operator()(AccRef acc, const Unit& u, int wr, int wc, int fr, int fq) const {
        const int c0 = u.pn * 256 + 32 * wc + 8 * fq;
        float bv[2][8];
        EPI_FOR_BJ ld8f(bias, (unsigned)(c0 + 128 * bj), bv[bj]);
#pragma unroll
        for (int ai = 0; ai < 2; ++ai) { EPI_FENCE; u32x4 yr[4][2], gr[4][2];
            EPI_FOR_M EPI_FOR_BJ { const unsigned o = (unsigned)(EPI_ROWX(ai, m) * D + c0 + 128 * bj); yr[m][bj] = ld8raw(YS, o); gr[m][bj] = ld8raw(GS, o); }
            EPI_FOR_M { const int row = EPI_ROWX(ai, m);
                EPI_FOR_BJ { EPI_GET8(v, bj); float y[8], g[8]; unpk8bf(yr[m][bj], y); unpk8bf(gr[m][bj], g);
#pragma unroll
                    for (int j = 0; j < 8; ++j) v[j] = y[j] * sigmoidf_(v[j] + bv[bj][j]) * g[j];
                    st8b_wt(Z, (unsigned)(row * D + c0 + 128 * bj), v); } } } } };
struct EpiSP { const bf16_t* GL; const bf16_t* MGA; bf16_t* MG;
    __device__ __forceinline__ void operator()(AccRef acc, const Unit& u, int wr, int wc, int fr, int fq) const {
        const int c0 = u.pn * 256 + 32 * wc + 8 * fq;
#pragma unroll
        for (int ai = 0; ai < 2; ++ai) { EPI_FENCE; u32x4 ar[4][2], gr[4][2];
            EPI_FOR_M EPI_FOR_BJ { const int row = EPI_ROWX(ai, m); gr[m][bj] = ld8raw(GL, (unsigned)(row * 2048 + D + c0 + 128 * bj)); ar[m][bj] = ld8raw(MGA, (unsigned)(row * D + c0 + 128 * bj)); }
            EPI_FOR_M { const int row = EPI_ROWX(ai, m);
                EPI_FOR_BJ { EPI_GET8(v, bj); float g[8], a[8]; unpk8bf(gr[m][bj], g); unpk8bf(ar[m][bj], a);
#pragma unroll
                    for (int j = 0; j < 8; ++j) v[j] = a[j] + g[j] * v[j];
                    st8b_wt(MG, (unsigned)(row * D + c0 + 128 * bj), v); } } } } };
struct EpiOut { bf16_t* XB; float* y; float* ssq; int next;
    __device__ __forceinline__ void operator()(AccRef acc, const Unit& u, int wr, int wc, int fr, int fq) const {
        const int c0 = u.pn * 256 + 32 * wc + 8 * fq;
        u32x4 xr[2][4][2];
#pragma unroll
        for (int ai = 0; ai < 2; ++ai) EPI_FOR_M EPI_FOR_BJ xr[ai][m][bj] = ld8raw(XB, (unsigned)(EPI_ROWX(ai, m) * D + c0 + 128 * bj));
#pragma unroll
        for (int ai = 0; ai < 2; ++ai) EPI_FOR_M { EPI_FENCE; const int row = EPI_ROWX(ai, m); float s = 0.f;
            EPI_FOR_BJ { EPI_GET8(v, bj); float x[8]; unpk8bf(xr[ai][m][bj], x);
#pragma unroll
                for (int j = 0; j < 8; ++j) { v[j] += x[j]; s += v[j] * v[j]; }
                if (next) st8b(XB, (unsigned)(row * D + c0 + 128 * bj), v); else st8f(y, (unsigned)(row * D + c0 + 128 * bj), v); }
            if (next) { s += __shfl_xor(s, 16); s += __shfl_xor(s, 32); if (fq == 0) ((GAS float*)ssq)[(unsigned)(row * 16 + u.pn * 4 + wc)] = s; } } } };

constexpr int AT_SLOT = 32768, AT_CB = 65536, AT_LS = 131072;
struct AttnJob { const bf16_t* Q; const bf16_t* K; const bf16_t* V; const bf16_t* GA; bf16_t* OA; const float* subg; int kmap; int nt; int qrow0, qpos0, head, sample; float lam, shift2, outscale; };
__device__ __forceinline__ int crow(int r, int hi) { return (r & 3) + 8 * (r >> 2) + 4 * hi; }
struct BgJob { const bf16_t* KTP; const bf16_t* VTP; float* okp; float* ovp; const float* ck; const float* cv; bf16_t* KTS; bf16_t* VTS; unsigned base; };
__device__ __forceinline__ void bg_issue(const BgJob& B, unsigned ib, int tid, u32x4& d0, u32x4& d1) {
    const unsigned kind = ib >> 21, i = (ib & 0x1FFFFFu) + (unsigned)tid;
    if (kind == 0) { const unsigned lp = i & 63, h = (i >> 6) & 7, m = (i >> 9) & 1, t = ((i >> 10) & 255) * 8 + (lp & 7), b = i >> 18, d8 = lp >> 3;
        d0 = ld8raw(B.KTP, (((b * 8 + h) * 2 + m) * 32 + (t >> 6)) * 4096 + (d8 >> 1) * 1024 + (d8 & 1) * 512 + (t & 63) * 8); }
    else if (kind == 1) { const unsigned lp = i & 63, h = (i >> 6) & 7, t = ((i >> 9) & 511) * 4 + (lp >> 4), b = i >> 18, e8 = lp & 15, kv = t & 63;
        d0 = ld8raw(B.VTP, ((b * 8 + h) * 32 + (t >> 6)) * 8192 + (e8 >> 2) * 2048 + (kv >> 4) * 512 + (kv & 15) * 32 + (e8 & 3) * 8); }
    else if (kind < 4) { const GAS u32x4* p = (const GAS u32x4*)((const GAS float*)(kind == 2 ? B.ck : B.cv) + i * 8); d0 = p[0]; d1 = p[1]; }
}
__device__ __forceinline__ void bg_commit(const BgJob& B, unsigned ib, int tid, const u32x4& d0, const u32x4& d1) {
    const unsigned kind = ib >> 21, i = (ib & 0x1FFFFFu) + (unsigned)tid;
    if (kind == 0) { const unsigned lp = i & 63, h = (i >> 6) & 7, m = (i >> 9) & 1, t = ((i >> 10) & 255) * 8 + (lp & 7), b = i >> 18, d8 = lp >> 3; float v[8]; unpk8bf(d0, v);
        st8f(B.okp, (b * T + t) * D + m * 512 + h * 64 + d8 * 8, v); }
    else if (kind == 1) { const unsigned lp = i & 63, h = (i >> 6) & 7, t = ((i >> 9) & 511) * 4 + (lp >> 4), b = i >> 18, e8 = lp & 15; float v[8]; unpk8bf(d0, v);
        st8f(B.ovp, (b * T + t) * D + h * 128 + e8 * 8, v); }
    else if (kind < 4) { const unsigned c8 = i & 127, t = (i >> 7) & (PAST - 1), b = i >> 17, col = c8 * 8;
        const float v[8] = {__uint_as_float(d0.x), __uint_as_float(d0.y), __uint_as_float(d0.z), __uint_as_float(d0.w), __uint_as_float(d1.x), __uint_as_float(d1.y), __uint_as_float(d1.z), __uint_as_float(d1.w)};
        if (kind == 2) { const unsigned mapi = col >> 9, head = (col >> 6) & 7, d8 = (col & 63) >> 3;
            st8b(B.KTS, (((b * NH + head) * 2 + mapi) * NTS + (t >> 6)) * 4096 + (d8 >> 1) * 1024 + (d8 & 1) * 512 + (t & 63) * 8, v); }
        else { const unsigned head = col >> 7, e = col & 127, kv = t & 63;
            st8b(B.VTS, ((b * NH + head) * NTS + (t >> 6)) * 8192 + (e >> 5) * 2048 + (kv >> 4) * 512 + (kv & 15) * 32 + (e & 31), v); } }
}
template <bool BG>
__device__ __forceinline__ void attn_unit(LAS unsigned char* lds, const AttnJob& J_, int tid_, const BgJob& Bg) {
    AttnJob J = J_; asm volatile("" : "+s"(J.head), "+s"(J.qpos0), "+s"(J.qrow0), "+s"(J.sample), "+s"(J.nt));
    int tid = tid_; asm volatile("" : "+v"(tid));
    const int lane = tid & 63, r32 = lane & 31, hi = lane >> 5; const int wid = __builtin_amdgcn_readfirstlane(tid >> 6), mapi = wid >> 2, sub = wid & 3;
    const float slope2 = __builtin_amdgcn_exp2f(-(float)(J.head + 1)) * LOG2E;
    const int tq0 = J.qpos0 + 32 * sub, tq = tq0 + (J.sample ? (r32 & 15) : r32);
    const int mychunk = tq0 >> 6;
    const int ntl = J.sample ? (sub == 0 ? J.nt : 0) : (mychunk + 1);
    const int qrow = J.qrow0 + 32 * sub + (J.sample ? (r32 & 15) : r32);
    const unsigned loff = (unsigned)lane * 16u;
    const GAS char* pbase; size_t pstr;
    if (wid < 4) { pbase = (const GAS char*)J.K + ((size_t)(wid >> 1) * J.kmap + (size_t)(wid & 1) * 2048) * 2; pstr = 8192; }
    else { pbase = (const GAS char*)J.V + (size_t)(wid - 4) * 4096; pstr = 16384; }
#define AT_DMA(t, sloff) do { const GAS char* p_ = pbase + (size_t)(t) * pstr; _Pragma("unroll") for (int _i = 0; _i < 4; ++_i) \
        __builtin_amdgcn_global_load_lds((const GAS unsigned*)(p_ + _i * 1024 + loff), (LAS unsigned*)(lds + (sloff) + (wid * 4 + _i) * 1024), 16, 0, 0); } while (0)
    AT_DMA(0, 0);
    if (J.nt > 1) AT_DMA(1, AT_SLOT);
    bf16x8 qr[4];
#pragma unroll
    for (int d0 = 0; d0 < 4; ++d0) qr[d0] = *(const bf16x8*)(J.Q + (size_t)qrow * D + J.head * 128 + mapi * 64 + d0 * 16 + hi * 8);
    f32x16 o[4];
#pragma unroll
    for (int e = 0; e < 4; ++e) o[e] = (f32x16){};
    float lsum = 0.f;
    const int koff = mapi * 8192 + hi * 1024 + r32 * 16;
    const int voff = 16384 + ((lane >> 4) & 1) * 32 + (lane & 3) * 8 + (4 * hi + ((lane & 15) >> 2)) * 64;
#define AT_QK(P0, P1, sloff) do { const LAS unsigned char* kb_ = lds + (sloff) + koff; bf16x8 kf_[4][2]; \
        _Pragma("unroll") for (int d0 = 0; d0 < 4; ++d0) { kf_[d0][0] = *(const LAS bf16x8*)(kb_ + d0 * 2048); kf_[d0][1] = *(const LAS bf16x8*)(kb_ + d0 * 2048 + 512); } \
        _Pragma("unroll") for (int d0 = 0; d0 < 4; ++d0) { \
            P0 = __builtin_amdgcn_mfma_f32_32x32x16_bf16(kf_[d0][0], qr[d0], d0 == 0 ? (f32x16){} : P0, 0, 0, 0); \
            P1 = __builtin_amdgcn_mfma_f32_32x32x16_bf16(kf_[d0][1], qr[d0], d0 == 0 ? (f32x16){} : P1, 0, 0, 0); } } while (0)
#define AT_VRD(ks) do { _Pragma("unroll") for (int eb = 0; eb < 4; ++eb) { \
        asm volatile("ds_read_b64_tr_b16 %0, %1 offset:%2" : "=v"(vlo[eb][ks]) : "v"(va), "i"(eb * 4096 + (ks) * 1024) : "memory"); \
        asm volatile("ds_read_b64_tr_b16 %0, %1 offset:%2" : "=v"(vhi[eb][ks]) : "v"(va), "i"(eb * 4096 + (ks) * 1024 + 512) : "memory"); } } while (0)
#define AT_PV(ks) do { _Pragma("unroll") for (int eb = 0; eb < 4; ++eb) { \
        const bf16x8 vf = {vlo[eb][ks][0], vlo[eb][ks][1], vlo[eb][ks][2], vlo[eb][ks][3], vhi[eb][ks][0], vhi[eb][ks][1], vhi[eb][ks][2], vhi[eb][ks][3]}; \
        o[eb] = __builtin_amdgcn_mfma_f32_32x32x16_bf16(__builtin_bit_cast(bf16x8, pw[ks]), vf, o[eb], 0, 0, 0); } } while (0)
#define AT_STEP(P0, P1, N0, N1, t) do { \
        if ((t) > 0) { VM_WAIT(); __syncthreads(); }                             \
        if (BG) { if ((t) > 0) bg_commit(Bg, bgb + ((t) - 1) * 512, tid, bd0, bd1); bg_issue(Bg, bgb + (t) * 512, tid, bd0, bd1); } \
        if ((t) + 2 < J.nt) AT_DMA((t) + 2, s_free); \
        if ((t) < ntl) { \
            if ((t) + 1 < ntl) AT_QK(N0, N1, s_nxt); \
            s16x4 vlo[4][4], vhi[4][4]; \
            const unsigned va = (unsigned)(uintptr_t)(lds + s_cur + voff);       \
            AT_VRD(0); \
            __builtin_amdgcn_sched_barrier(0); \
            if ((t) < mychunk) {                                                 \
                const float base = slope2 * (float)(64 * (t) + 4 * hi - tq) - J.shift2, base1 = base + 32.0f * slope2; \
                _Pragma("unroll") for (int r = 0; r < 16; ++r) { const float kr = slope2 * (float)((r & 3) + 8 * (r >> 2)); P0[r] += kr + base; P1[r] += kr + base1; } \
            } else { \
                _Pragma("unroll") for (int r = 0; r < 16; ++r) { const int kr = crow(r, hi); const float d0 = (float)(64 * (t) + kr - tq); \
                    P0[r] += -slope2 * __builtin_fabsf(d0) - J.shift2; P1[r] += -slope2 * __builtin_fabsf(d0 + 32.0f) - J.shift2; \
                    if (J.sample) { if (kr >= DS) P0[r] = -1e30f; P1[r] = -1e30f; } } \
            } \
            float sa = 0.f, sb = 0.f; \
            _Pragma("unroll") for (int r = 0; r < 16; ++r) { P0[r] = __builtin_amdgcn_exp2f(P0[r]); P1[r] = __builtin_amdgcn_exp2f(P1[r]); sa += P0[r]; sb += P1[r]; } \
            lsum += sa + sb; \
            u32x4 pw[4]; \
            _Pragma("unroll") for (int k = 0; k < 4; ++k) { pw[0][k] = pk2bf(P0[2 * k], P0[2 * k + 1]); pw[1][k] = pk2bf(P0[8 + 2 * k], P0[9 + 2 * k]); pw[2][k] = pk2bf(P1[2 * k], P1[2 * k + 1]); pw[3][k] = pk2bf(P1[8 + 2 * k], P1[9 + 2 * k]); } \
            asm volatile("s_waitcnt lgkmcnt(0)" ::: "memory"); __builtin_amdgcn_sched_barrier(0); \
            AT_VRD(1); AT_PV(0); asm volatile("s_waitcnt lgkmcnt(0)" ::: "memory"); __builtin_amdgcn_sched_barrier(0); \
            AT_VRD(2); AT_PV(1); asm volatile("s_waitcnt lgkmcnt(0)" ::: "memory"); __builtin_amdgcn_sched_barrier(0); \
            AT_VRD(3); AT_PV(2); asm volatile("s_waitcnt lgkmcnt(0)" ::: "memory"); __builtin_amdgcn_sched_barrier(0); \
            AT_PV(3); \
        } \
        { const int tmp_ = s_cur; s_cur = s_nxt; s_nxt = s_free; s_free = tmp_; } } while (0)
    int s_cur = 0, s_nxt = AT_SLOT, s_free = 2 * AT_SLOT;
    u32x4 bd0 = {0u, 0u, 0u, 0u}, bd1 = {0u, 0u, 0u, 0u}; unsigned bgb = Bg.base; asm volatile("" : "+s"(bgb));
    f32x16 a0, a1, b0, b1;
    VM_WAIT(); __syncthreads();
    if (ntl > 0) AT_QK(a0, a1, 0);
    for (int t = 0; t < J.nt; t += 2) {
        AT_STEP(a0, a1, b0, b1, t);
        if (t + 1 < J.nt) AT_STEP(b0, b1, a0, a1, t + 1);
    }
#undef AT_DMA
#undef AT_QK
#undef AT_STEP
#undef AT_VRD
#undef AT_PV
    lsum += __shfl_xor(lsum, 32);
    LAS float* ls = (LAS float*)(lds + AT_LS) + wid * 32;
    LAS float* cb = (LAS float*)(lds + AT_CB) + sub * 4096;
    const bool act = ntl > 0;
    __syncthreads();
    if (BG) bg_commit(Bg, bgb + (J.nt - 1) * 512, tid, bd0, bd1);
    if (act) {
        if (hi == 0) ls[r32] = lsum;
        LDS_WAIT();
        float f[16];
#pragma unroll
        for (int r = 0; r < 16; ++r) f[r] = (mapi ? J.lam : 1.0f) * __builtin_amdgcn_rcpf(ls[crow(r, hi)]);
#pragma unroll
        for (int eb = 0; eb < 4; ++eb)
#pragma unroll
            for (int r = 0; r < 16; ++r) o[eb][r] *= f[r];
        if (mapi) {
#pragma unroll
            for (int eb = 0; eb < 4; ++eb)
#pragma unroll
                for (int r = 0; r < 16; ++r) cb[(eb * 16 + r) * 64 + lane] = o[eb][r];
        }
    }
    __syncthreads();
    if (act && mapi == 0) {
        float ss[16];
#pragma unroll
        for (int r = 0; r < 16; ++r) ss[r] = 0.f;
#pragma unroll
        for (int eb = 0; eb < 4; ++eb)
#pragma unroll
            for (int r = 0; r < 16; ++r) { o[eb][r] -= cb[(eb * 16 + r) * 64 + lane]; ss[r] += o[eb][r] * o[eb][r]; }
#pragma unroll
        for (int r = 0; r < 16; ++r) { float s = ss[r]; s += __shfl_xor(s, 1); s += __shfl_xor(s, 2); s += __shfl_xor(s, 4); s += __shfl_xor(s, 8); s += __shfl_xor(s, 16);
            ss[r] = __builtin_amdgcn_rsqf(s * (1.0f / VD) + EPS) * J.outscale; }
#pragma unroll
        for (int eb = 0; eb < 4; ++eb) { const int e = eb * 32 + r32; const float sg = J.subg[e];
#pragma unroll
            for (int r = 0; r < 16; ++r) { const int qi = crow(r, hi);
                if (!J.sample || qi < DS) { const size_t idx = (size_t)(J.qrow0 + 32 * sub + qi) * D + J.head * VD + e;
                    J.OA[idx] = f2bf(o[eb][r] * ss[r] * sg * bf2f(J.GA[idx])); } } }
    }
}

#define XB_TMO      128
#define XB_XCNT(j)  (256  + 64 * (j))
#define XB_XSUB(j)  (1280 + 64 * (j))
#define XB_XGEN(j)  (2304 + 64 * (j))
#define XB_TOP      3328
#define XB_TOPGEN   3392
#define XCD_BAR_WORDS 3456
#define XB_SPIN_CAP (1u << 20)
__device__ __forceinline__ unsigned xb_ld(unsigned* p)              { return __hip_atomic_load(p, __ATOMIC_RELAXED, __HIP_MEMORY_SCOPE_AGENT); }
__device__ __forceinline__ unsigned xb_add(unsigned* p, unsigned v) { return __hip_atomic_fetch_add(p, v, __ATOMIC_RELAXED, __HIP_MEMORY_SCOPE_AGENT); }
__device__ __forceinline__ unsigned xb_xcc_id() { return (unsigned)__builtin_amdgcn_s_getreg((3 << 11) | 20) & 0xFu; }
#define XB_SPIN(cond, bar) do { unsigned _sp = 0; while (cond) { __builtin_amdgcn_s_sleep(1); \
    if ((++_sp & 255u) == 0u) { if (xb_ld(&(bar)[XB_TMO])) break; if (_sp > XB_SPIN_CAP) { atomicAdd(&(bar)[XB_TMO], 1u); break; } } } } while (0)
struct XcdBarrier { unsigned* bar; unsigned x; volatile LAS unsigned* st; };
__device__ __forceinline__ XcdBarrier xcd_barrier_post(unsigned* bar, volatile LAS unsigned* st, int tid) {
    XcdBarrier b; b.bar = bar; b.x = xb_xcc_id(); b.st = st;
    if (tid == 0) (void)xb_add(&bar[XB_XCNT(b.x)], 1u);
    return b;
}
__device__ __forceinline__ void xcd_barrier_complete(unsigned* bar, unsigned x, unsigned& nloc, unsigned& nx) {
    const unsigned G = gridDim.x * gridDim.y * gridDim.z;
    unsigned sum, cnt, mine, sp = 0u;
    for (;;) {
        sum = 0u; cnt = 0u; mine = 0u;
#pragma unroll
        for (unsigned j = 0; j < 16; ++j) { const unsigned c = xb_ld(&bar[XB_XCNT(j)]); sum += c; cnt += (c > 0u) ? 1u : 0u; mine = (j == x) ? c : mine; }
        if (sum == G) break;
        __builtin_amdgcn_s_sleep(1);
        if ((++sp & 255u) == 0u) { if (xb_ld(&bar[XB_TMO])) break; if (sp > XB_SPIN_CAP) { atomicAdd(&bar[XB_TMO], 1u); break; } }
    }
    nloc = mine > 0u ? mine : 1u; nx = cnt > 0u ? cnt : 1u;
}
__device__ __forceinline__ void xcd_barrier(const XcdBarrier& b, int wave0) {
    asm volatile("s_waitcnt vmcnt(0)" ::: "memory");
    __syncthreads();
    if (wave0 * 64 + lane_id() == 0) {
        unsigned* bar = b.bar; unsigned bx_ = b.x; asm volatile("" : "+s"(bar), "+s"(bx_));
        __builtin_amdgcn_s_waitcnt(0);
        unsigned nloc = b.st[0], nx = b.st[1];
        if (nloc == 0u) { xcd_barrier_complete(bar, bx_, nloc, nx); b.st[0] = nloc; b.st[1] = nx; }
        const unsigned old = xb_add(&bar[XB_XSUB(bx_)], 1u);
        const unsigned gen = old / nloc;
        if (old + 1u == (gen + 1u) * nloc) {
            __builtin_amdgcn_fence(__ATOMIC_RELEASE, "agent");
            asm volatile("s_waitcnt vmcnt(0)" ::: "memory");
            const unsigned og = xb_add(&bar[XB_TOP], 1u);
            const unsigned tg = og / nx;
            if (og + 1u == (tg + 1u) * nx) xb_add(&bar[XB_TOPGEN], 1u);
            else XB_SPIN(xb_ld(&bar[XB_TOPGEN]) == tg, bar);
            __builtin_amdgcn_fence(__ATOMIC_ACQUIRE, "agent");
            xb_add(&bar[XB_XGEN(bx_)], 1u);
            asm volatile("s_waitcnt vmcnt(0)" ::: "memory");
        } else {
            XB_SPIN(xb_ld(&bar[XB_XGEN(bx_)]) == gen, bar);
            __builtin_amdgcn_fence(__ATOMIC_ACQUIRE, "agent");
            asm volatile("s_waitcnt vmcnt(0)" ::: "memory");
        }
    }
    __syncthreads();
}

constexpr int CW_CHAIN = 8192;
__device__ __forceinline__ unsigned* chain_cnt(unsigned char* ws, int l, int type, int pm) { return (unsigned*)(ws + WS_CTL) + CW_CHAIN + ((l * 3 + type) * 65 + pm) * 16; }
__device__ __forceinline__ void chain_wait(unsigned* c0, unsigned* c1, unsigned need, int tid) {
    if (tid == 0) { unsigned sp = 0;
        for (;;) { const unsigned a = xb_ld(c0), b = c1 ? xb_ld(c1) : need; if (a >= need && b >= need) break; __builtin_amdgcn_s_sleep(2); if (++sp > (1u << 22)) break; }
        __builtin_amdgcn_fence(__ATOMIC_ACQUIRE, "agent"); asm volatile("s_waitcnt vmcnt(0)" ::: "memory"); }
    __syncthreads();
}
__device__ __forceinline__ void chain_signal(unsigned* c, int tid) {
    if (tid == 0) { asm volatile("s_waitcnt vmcnt(0)" ::: "memory"); (void)xb_add(c, 1u); }
}
#ifndef PHM
#define PHM 0xFFFF
#endif
#define PH(k) ((PHM >> (k)) & 1)
#ifndef REP
#define REP -1
#endif
#define REPN(k) ((REP == (k)) ? 2 : 1)
constexpr int NWAVES = 8, NTHREADS = 512;
constexpr int LDS_BYTES = 147456, MISC_OFF = 131072 + 1024 + 320;
struct Args { const float* in[28]; float* out; unsigned char* ws; };

__device__ __forceinline__ float wave_sum(float v) {
#pragma unroll
    for (int o = 1; o < 64; o <<= 1) v += __shfl_xor(v, o);
    return v;
}
__device__ __forceinline__ void transpose_item(const float* W, int K, int N, bf16_t* WT, LAS float* scr, int item, int lane, const float* kscale, bool headperm) {
    const int nblk = N / 32, kb = item / nblk, nb = item % nblk, k0 = 64 * kb, n0 = 32 * nb;
#pragma unroll 8
    for (int i = 0; i < 32; ++i) { const int kk = 2 * i + (lane >> 5); float v = W[(size_t)(k0 + kk) * N + n0 + (lane & 31)]; if (kscale) v *= kscale[k0 + kk]; scr[kk * 33 + (lane & 31)] = v; }
    LDS_WAIT(); asm volatile("" ::: "memory");
    int rbase = n0; if (headperm && n0 < 2048) { const int l = n0 & 255; rbase = (n0 & ~255) + 128 * ((l >> 5) & 1) + 32 * (l >> 6); }
    const int c = lane & 7;
#pragma unroll
    for (int j = 0; j < 4; ++j) { const int n = (lane >> 3) + 8 * j; const LAS float* s = scr + (8 * c) * 33 + n;
        u32x4 o; o.x = pk2bf(s[0 * 33], s[1 * 33]); o.y = pk2bf(s[2 * 33], s[3 * 33]); o.z = pk2bf(s[4 * 33], s[5 * 33]); o.w = pk2bf(s[6 * 33], s[7 * 33]);
        *(u32x4*)(WT + (size_t)(rbase + n) * K + k0 + 8 * c) = o; }
    LDS_WAIT(); asm volatile("" ::: "memory");
}

__device__ __forceinline__ void tables_prep(LAS float* AP, LAS float* BB, LAS float* CT, const __attribute__((address_space(4))) Args* Ap, int l, int g, int tid, bool want_bb, float* a32) {
    const float* lre = Ap->in[16] + (size_t)l * NG * SP; const float* lim = Ap->in[17] + (size_t)l * NG * SP; const float* ldt = Ap->in[18] + (size_t)l * NG;
    const float* cre = Ap->in[21] + (size_t)l * NG * GC * SP; const float* cim = Ap->in[22] + (size_t)l * NG * GC * SP;
    {
        const int p = tid & 63, t0 = tid >> 6; const float lr = lre[g * SP + p], li = lim[g * SP + p], dt = __expf(ldt[g]);
        for (int tau = t0; tau <= 32; tau += 8) { const float mg = __expf(lr * dt * (float)tau); float tr = li * dt * (float)tau * 0.15915494309189535f; tr -= rintf(tr);
            AP[(tau * 64 + p) * 2] = mg * __builtin_amdgcn_cosf(tr); AP[(tau * 64 + p) * 2 + 1] = mg * __builtin_amdgcn_sinf(tr); }
    }
    for (int i = tid; i < GC * SP; i += NTHREADS) { CT[i * 2] = cre[(size_t)g * GC * SP + i]; CT[i * 2 + 1] = cim[(size_t)g * GC * SP + i]; }
    __syncthreads();
    if (want_bb && tid < 64) { const int p = tid; const float lr = lre[g * SP + p], li = lim[g * SP + p];
        const float* bre = Ap->in[19] + (size_t)l * NG * SP * GC; const float* bim = Ap->in[20] + (size_t)l * NG * SP * GC;
        const float ar = AP[(64 + p) * 2], ai = AP[(64 + p) * 2 + 1], zr = ar - 1.0f, zi = ai, den = lr * lr + li * li;
        const float wre = (zr * lr + zi * li) / den, wim = (zi * lr - zr * li) / den;
        for (int n = 0; n < GC; ++n) { const float br = bre[(g * SP + p) * GC + n], bi = bim[(g * SP + p) * GC + n]; BB[(p * GC + n) * 2] = wre * br - wim * bi; BB[(p * GC + n) * 2 + 1] = wre * bi + wim * br; }
        a32[(size_t)(g * SP + p) * 2] = AP[(32 * 64 + p) * 2]; a32[(size_t)(g * SP + p) * 2 + 1] = AP[(32 * 64 + p) * 2 + 1];
    }
}
__device__ __forceinline__ void tables_gen(LAS unsigned char* lds, const __attribute__((address_space(4))) Args* Ap, int l, int g, int tid) {
    LAS float* AP = (LAS float*)lds;
    LAS float* BB = AP + 33 * 64 * 2;
    LAS float* CT = BB + 64 * 16 * 2;
    const float* dsk = Ap->in[23] + (size_t)l * D;
    __syncthreads();
    tables_prep(AP, BB, CT, Ap, l, g, tid, true, (float*)(Ap->ws + WS_SCAL) + SC_A32 + (size_t)l * NG * SP * 2);
    __syncthreads();
    {
        const int tau = tid >> 4, no = tid & 15; float a[GC];
#pragma unroll
        for (int n = 0; n < GC; ++n) a[n] = 0.f;
        for (int p = 0; p < SP; ++p) { const f32x2 c = *(const LAS f32x2*)(CT + (no * SP + p) * 2), w = *(const LAS f32x2*)(AP + (tau * 64 + p) * 2);
            const float xr = c[0] * w[0] - c[1] * w[1], xi = c[0] * w[1] + c[1] * w[0];
#pragma unroll
            for (int n2 = 0; n2 < GC / 2; ++n2) { const f32x4 b = *(const LAS f32x4*)(BB + (p * GC + 2 * n2) * 2); a[2 * n2] += xr * b[0] - xi * b[1]; a[2 * n2 + 1] += xr * b[2] - xi * b[3]; } }
        if (tau == 0) { const float dv = dsk[g * GC + no];
#pragma unroll
            for (int n = 0; n < GC; ++n) if (n == no) a[n] += dv; }
        float* kcg = (float*)(Ap->ws + WS_KCG) + ((size_t)(l * NG + g) * LC * GC + tid) * GC;
#pragma unroll
        for (int n4 = 0; n4 < 4; ++n4) *(GAS f32x4*)((GAS float*)kcg + 4 * n4) = (f32x4){a[4 * n4], a[4 * n4 + 1], a[4 * n4 + 2], a[4 * n4 + 3]};
    }
    bf16_t* BT1 = (bf16_t*)(Ap->ws + WS_BT1) + ((size_t)l * (NG + 1) + g) * 128 * (LC * GC);
    for (int ch = tid; ch < 128 * 64; ch += NTHREADS) {
        const int row = ch >> 6, k8 = ch & 63, part = row >> 6, p = row & 63, k = k8 * 8, s = k >> 4, ni0 = k & 15; float v[8];
        const float pr = AP[((31 - s) * 64 + p) * 2], pim = AP[((31 - s) * 64 + p) * 2 + 1];
#pragma unroll
        for (int i = 0; i < 8; ++i) { const float br = BB[(p * GC + ni0 + i) * 2], bi = BB[(p * GC + ni0 + i) * 2 + 1]; v[i] = part == 0 ? (pr * br - pim * bi) : (pr * bi + pim * br); }
        st8b(BT1, (unsigned)(row * (LC * GC) + k), v);
    }
    __syncthreads();
}
__device__ __forceinline__ void tables_expand(LAS unsigned char* lds, const __attribute__((address_space(4))) Args* Ap, int l, int unit, int tid) {
    const int g = unit >> 2, q4 = unit & 3;
    LAS float* AP = (LAS float*)lds;
    LAS float* BB = AP + 33 * 64 * 2;
    LAS float* CT = BB + 64 * 16 * 2;
    LAS float* KC = CT + 16 * 64 * 2;
    __syncthreads();
    { const float* kcg = (const float*)(Ap->ws + WS_KCG) + (size_t)(l * NG + g) * LC * GC * GC;
      for (int i = tid; i < LC * GC * GC / 4; i += NTHREADS) *(LAS f32x4*)(KC + 4 * i) = *(const GAS f32x4*)((const GAS float*)kcg + 4 * i); }
    tables_prep(AP, BB, CT, Ap, l, g, tid, false, nullptr);
    __syncthreads();
    bf16_t* BT2 = (bf16_t*)(Ap->ws + WS_BT2) + (size_t)g * (LC * GC) * KX;
    for (int ch = tid; ch < 128 * (KX / 8); ch += NTHREADS) {
        const int rl = ch / (KX / 8), k8 = ch % (KX / 8), row = q4 * 128 + rl, j = row >> 4, no = row & 15, k = k8 * 8; float v[8];
        if (k < LC * GC) { const int s = k >> 4, ni0 = k & 15, tau = j - s;
            if (tau >= 0) { const f32x4 a = *(const LAS f32x4*)(KC + (tau * GC + no) * GC + ni0), b = *(const LAS f32x4*)(KC + (tau * GC + no) * GC + ni0 + 4);
                v[0] = a[0]; v[1] = a[1]; v[2] = a[2]; v[3] = a[3]; v[4] = b[0]; v[5] = b[1]; v[6] = b[2]; v[7] = b[3]; }
            else {
#pragma unroll
                for (int i = 0; i < 8; ++i) v[i] = 0.f; }
        } else { const int pi0 = k - LC * GC, part = pi0 >> 6, p0 = pi0 & 63;
#pragma unroll
            for (int i = 0; i < 8; ++i) { const int p = p0 + i; const float cr = CT[(no * SP + p) * 2], ci = CT[(no * SP + p) * 2 + 1], pr = AP[((j + 1) * 64 + p) * 2], pim = AP[((j + 1) * 64 + p) * 2 + 1];
                v[i] = part == 0 ? (cr * pr - ci * pim) : -(cr * pim + ci * pr); } }
        st8b(BT2, (unsigned)(row * KX + k), v);
    }
    __syncthreads();
}

typedef const __attribute__((address_space(4))) Args* ArgsP;
__device__ __forceinline__ ArgsP fresh_args() { ArgsP p = (ArgsP)__builtin_amdgcn_kernarg_segment_ptr(); asm volatile("" : "+s"(p)); return p; }
#define WSP(T, off) ((T*)(ws + (off)))
__global__ void __launch_bounds__(NTHREADS, 2) mega_fwd(Args A_unused) {
    extern __shared__ __attribute__((aligned(16))) unsigned char lds_raw[];
    LAS unsigned char* lds = (LAS unsigned char*)lds_raw;
    volatile LAS unsigned* MISC = (volatile LAS unsigned*)(lds + MISC_OFF);
    const int G0 = gridDim.x, bx0 = blockIdx.x;
    const int wave0 = __builtin_amdgcn_readfirstlane((int)threadIdx.x >> 6);
    if (wave0 == 0 && lane_id() < 32) MISC[lane_id()] = 0u;
    __syncthreads();
    XcdBarrier bar = xcd_barrier_post((unsigned*)(fresh_args()->ws + WS_CTL) + 4096, MISC + 8, wave0 * 64 + lane_id());
#define PHASE_BEGIN const ArgsP A = fresh_args(); unsigned char* const ws = A->ws; int tid = wave0 * 64 + lane_id(); asm volatile("" : "+v"(tid)); \
    int G = G0, bx = bx0; asm volatile("" : "+s"(G), "+s"(bx)); const int vcu = (G % 8 == 0) ? (bx % 8) * (G / 8) + bx / 8 : bx; \
    const int lane = tid & 63, wave = __builtin_amdgcn_readfirstlane(tid >> 6), gw = vcu * NWAVES + wave, NGW = G * NWAVES; (void)lane; (void)gw; (void)NGW; (void)ws; (void)vcu;

#if PH(0)
for (int rep_ = 0; rep_ < REPN(0); ++rep_)
    {
        PHASE_BEGIN
        bf16_t* XB = WSP(bf16_t, WS_XB); float* SSQ = WSP(float, WS_SSQ); float* scal = WSP(float, WS_SCAL); bf16_t* KTS = WSP(bf16_t, WS_KTS); bf16_t* VTS = WSP(bf16_t, WS_VTS);
        LAS float* scr = (LAS float*)(lds + wave * 16384);
        constexpr int I_IN = (D / 64) * (INC / 32), I_SM = (D / 64) * (D / 32), I_L = I_IN + 4 * I_SM;
        for (int it = gw; it < DEPTH * I_L; it += NGW) {
            const int l = it / I_L; int r = it % I_L;
            if (r < I_IN) { transpose_item(A->in[7] + (size_t)l * D * INC, D, INC, WSP(bf16_t, WS_WIN) + (size_t)l * INC * D, scr, r, lane, A->in[6] + l * D, true); continue; }
            r -= I_IN; const int w = r / I_SM; r %= I_SM;
            const float* src = (w == 0 ? A->in[15] : w == 1 ? A->in[24] : w == 2 ? A->in[26] : A->in[27]) + (size_t)l * D * D;
            transpose_item(src, D, D, WSP(bf16_t, WS_WSM) + (size_t)(l * 4 + w) * D * D, scr, r, lane, nullptr, false);
        }
        for (int m = gw; m < MT; m += NGW) {
            const float* xr = (m < MP ? A->in[0] + (size_t)m * D : A->in[1] + (size_t)(m - MP) * D); float s = 0.f;
#pragma unroll
            for (int j = 0; j < 4; ++j) { const f32x4 v = *(const f32x4*)(xr + j * 256 + lane * 4); s += (v[0] * v[0] + v[1] * v[1]) + (v[2] * v[2] + v[3] * v[3]);
                u32x2 w; w.x = pk2bf(v[0], v[1]); w.y = pk2bf(v[2], v[3]); *(u32x2*)(XB + (size_t)m * D + j * 256 + lane * 4) = w; }
            s = wave_sum(s);
            if (lane < 16) SSQ[(size_t)m * 16 + lane] = lane == 0 ? s : 0.f;
        }
        if (bx == 0 && wave < DEPTH) {
            const int l = wave; const float a = A->in[10][l * HD + lane] * A->in[11][l * HD + lane], b = A->in[12][l * HD + lane] * A->in[13][l * HD + lane];
            const float s1 = wave_sum(a), s2 = wave_sum(b);
            float mq = __builtin_fabsf(A->in[8][l * HD + lane]), mk = __builtin_fabsf(A->in[9][l * HD + lane]);
#pragma unroll
            for (int o = 1; o < 64; o <<= 1) { mq = __builtin_fmaxf(mq, __shfl_xor(mq, o)); mk = __builtin_fmaxf(mk, __shfl_xor(mk, o)); }
            const float lam_init = 0.8f - 0.6f * __expf(-0.3f * (float)l);
            if (lane == 0) { scal[l * 8 + 0] = __expf(s1) - __expf(s2) + lam_init; scal[l * 8 + 1] = 8.0f * mq * mk * LOG2E; scal[l * 8 + 2] = 1.0f - lam_init; }
        }
        for (int i = gw * 64 + lane; i < DB * NH * 2 * (4096 / 8); i += NGW * 64) { const int img = i / 512, ch = i % 512; *(u32x4*)(KTS + ((size_t)img * NTS + NTS - 1) * 4096 + ch * 8) = (u32x4){0u, 0u, 0u, 0u}; }
        for (int i = gw * 64 + lane; i < DB * NH * (8192 / 8); i += NGW * 64) { const int img = i / 1024, ch = i % 1024; *(u32x4*)(VTS + ((size_t)img * NTS + NTS - 1) * 8192 + ch * 8) = (u32x4){0u, 0u, 0u, 0u}; }
        __syncthreads();
        for (int un = vcu; un < DEPTH * NG; un += G) tables_gen(lds, A, un / NG, un % NG, tid);
    }
#endif
    xcd_barrier(bar, wave0);

#if REP == 20
    for (int q_ = 0; q_ < 16; ++q_) xcd_barrier(bar, wave0);
#endif
#pragma unroll 1
    for (int l = 0; l < DEPTH; ++l) {
#if PH(1)
for (int rep_ = 0; rep_ < (l == 0 ? REPN(1) : 1); ++rep_)
        {
            PHASE_BEGIN
            float* out = A->out;
            pg8::Gemm g{WSP(bf16_t, WS_XB), WSP(bf16_t, WS_WIN) + (size_t)l * INC * D, D, D, D, 0, 0}; pg8::TileOrder S; S.init(MT / 256, INC / 256, 1, G, bx);
            EpiIn E{WSP(float, WS_SSQ), A->in[8] + l * HD, A->in[9] + l * HD, out + O_KP + (size_t)l * MP * D, out + O_VP + (size_t)l * MP * D, out + O_KS + (size_t)l * MS * D, out + O_VS + (size_t)l * MS * D,
                    WSP(bf16_t, WS_QB), WSP(bf16_t, WS_KTP), WSP(bf16_t, WS_VTP), WSP(bf16_t, WS_KTS), WSP(bf16_t, WS_VTS), WSP(bf16_t, WS_GA), WSP(bf16_t, WS_UX), WSP(bf16_t, WS_GS), WSP(bf16_t, WS_GL), WSP(float, WS_US)};
            pg8::gemm_phase(lds, g, S, E, tid);
        }
#endif
        xcd_barrier(bar, wave0);

#if PH(2)
        for (int rep_ = 0; rep_ < (l == 0 ? REPN(10) : 1); ++rep_)
        {
            PHASE_BEGIN
            const float* scal = WSP(float, WS_SCAL); float* out = A->out;
            AttnJob J; J.GA = WSP(bf16_t, WS_GA); J.OA = WSP(bf16_t, WS_OA); J.subg = A->in[14] + l * VD; J.lam = scal[l * 8 + 0]; J.shift2 = scal[l * 8 + 1]; J.outscale = scal[l * 8 + 2]; J.Q = WSP(bf16_t, WS_QB);
            BgJob B; B.KTP = WSP(bf16_t, WS_KTP); B.VTP = WSP(bf16_t, WS_VTP); B.okp = out + O_KP + (size_t)l * MP * D; B.ovp = out + O_VP + (size_t)l * MP * D;
            B.ck = A->in[2] + (size_t)l * DB * PAST * D; B.cv = A->in[3] + (size_t)l * DB * PAST * D; B.KTS = WSP(bf16_t, WS_KTS); B.VTS = WSP(bf16_t, WS_VTS);
            for (int it = vcu; it < 512; it += G) {
                const int bh = it >> 3, s = it & 7, b = bh >> 3, h = bh & 7;
                J.K = WSP(bf16_t, WS_KTP) + (size_t)(bh * 2) * (T / 64) * 4096; J.kmap = (T / 64) * 4096; J.V = WSP(bf16_t, WS_VTP) + (size_t)bh * (T / 64) * 8192; J.head = h; J.sample = 0;
#pragma unroll 1
                for (int k = 0; k < 2; ++k) { const int qb = k ? 15 - s : s; J.qrow0 = b * T + qb * 128; J.qpos0 = qb * 128; J.nt = 2 * qb + 2;
                    B.base = (unsigned)((it * 34 + (k ? 2 * s + 2 : 0)) * 512); attn_unit<true>(lds, J, tid, B); }
            }
            __syncthreads();
        }
#if PH(12)
        for (int rep_ = 0; rep_ < (l == 0 ? REPN(12) : 1); ++rep_)
        {
            PHASE_BEGIN
            pg8::Gemm g{WSP(bf16_t, WS_UX), WSP(bf16_t, WS_BT1) + (size_t)l * (NG + 1) * 128 * LC * GC, KX, LC * GC, LC * GC, (size_t)NPAIR * KX, (size_t)128 * LC * GC}; pg8::TileOrder S; S.init(2, 1, NG, 128, bx >= 128 ? bx - 128 : -1);
            EpiS1 E{WSP(float, WS_HF)};
            pg8::gemm_phase(lds, g, S, E, tid);
        }
#endif
#endif
        xcd_barrier(bar, wave0);

#if PH(3)
for (int rep_ = 0; rep_ < (l == 0 ? REPN(3) : 1); ++rep_)
        {
            PHASE_BEGIN
            float* out = A->out; float* HF = WSP(float, WS_HF); bf16_t* UX = WSP(bf16_t, WS_UX); bf16_t* YS = WSP(bf16_t, WS_YS); const float* US = WSP(float, WS_US);
            const float* a32t = WSP(float, WS_SCAL) + SC_A32 + (size_t)l * NG * SP * 2;
            const bool split = G > DB * NH; const int gw2 = split ? (bx - DB * NH) * NWAVES + wave : gw, NGW2 = split ? (G - DB * NH) * NWAVES : NGW;
            if (bx < DB * NH) {
                const float* scal = WSP(float, WS_SCAL);
                AttnJob J; J.GA = WSP(bf16_t, WS_GA); J.OA = WSP(bf16_t, WS_OA); J.subg = A->in[14] + l * VD; J.lam = scal[l * 8 + 0]; J.shift2 = scal[l * 8 + 1]; J.outscale = scal[l * 8 + 2]; J.Q = WSP(bf16_t, WS_QB);
                const int bh = bx, b = bh >> 3, h = bh & 7;
                J.K = WSP(bf16_t, WS_KTS) + (size_t)(bh * 2) * NTS * 4096; J.kmap = NTS * 4096; J.V = WSP(bf16_t, WS_VTS) + (size_t)bh * NTS * 8192; J.head = h; J.sample = 1;
                J.qrow0 = MP + b * DS; J.qpos0 = PAST; J.nt = NTS; BgJob B{}; attn_unit<false>(lds, J, tid, B);
                __syncthreads();
            }
            if (!split || bx >= DB * NH) {
            for (int it = gw2; it < NB * NG; it += NGW2) {
                const int b = it >> 6, g = it & 63, p = lane; const float ar = a32t[(g * SP + p) * 2], ai = a32t[(g * SP + p) * 2 + 1];
                const float* hf = HF + ((size_t)g * NPAIR + b * 64) * 128; bf16_t* ux = UX + ((size_t)g * NPAIR + b * 64) * KX + LC * GC;
                float hr = 0.f, hi_ = 0.f;
#pragma unroll 1
                for (int c0 = 0; c0 < 64; c0 += 16) { float fr_[16], fi_[16];
#pragma unroll
                    for (int c = 0; c < 16; ++c) { fr_[c] = hf[(size_t)(c0 + c) * 128 + p]; fi_[c] = hf[(size_t)(c0 + c) * 128 + 64 + p]; }
#pragma unroll
                    for (int c = 0; c < 16; ++c) { ux[(size_t)(c0 + c) * KX + p] = f2bf(hr); ux[(size_t)(c0 + c) * KX + 64 + p] = f2bf(hi_);
                        const float nr = ar * hr - ai * hi_ + fr_[c], ni = ar * hi_ + ai * hr + fi_[c]; hr = nr; hi_ = ni; } }
                out[O_HRP + ((size_t)(l * NB + b) * NG + g) * SP + p] = hr; out[O_HIP + ((size_t)(l * NB + b) * NG + g) * SP + p] = hi_;
            }
            LAS float* hs = (LAS float*)(lds + wave * 8192);
            for (int it = gw2; it < DB * NG; it += NGW2) {
                const int b = it >> 6, g = it & 63, p = lane;
                const float lr = A->in[16][(size_t)(l * NG + g) * SP + p], li = A->in[17][(size_t)(l * NG + g) * SP + p], dt = __expf(A->in[18][l * NG + g]);
                const float mg = __expf(lr * dt); float tr = li * dt * 0.15915494309189535f; tr -= rintf(tr);
                const float ar = mg * __builtin_amdgcn_cosf(tr), ai = mg * __builtin_amdgcn_sinf(tr), zr = ar - 1.0f, zi = ai, den = lr * lr + li * li;
                const float wre = (zr * lr + zi * li) / den, wim = (zi * lr - zr * li) / den;
                float bbr[GC], bbi[GC];
#pragma unroll
                for (int n = 0; n < GC; ++n) { const float br = A->in[19][((size_t)(l * NG + g) * SP + p) * GC + n], bi = A->in[20][((size_t)(l * NG + g) * SP + p) * GC + n]; bbr[n] = wre * br - wim * bi; bbi[n] = wre * bi + wim * br; }
                float hr = A->in[4][((size_t)(l * DB + b) * NG + g) * SP + p], hi_ = A->in[5][((size_t)(l * DB + b) * NG + g) * SP + p];
                const float* ub = US + (size_t)(b * DS) * D + g * GC;
#pragma unroll 1
                for (int t = 0; t < DS; ++t) { float bur = 0.f, bui = 0.f;
#pragma unroll
                    for (int n = 0; n < GC; ++n) { const float uv = ub[(size_t)t * D + n]; bur += uv * bbr[n]; bui += uv * bbi[n]; }
                    const float nr = ar * hr - ai * hi_ + bur, ni = ar * hi_ + ai * hr + bui; hr = nr; hi_ = ni;
                    hs[(t * 64 + p) * 2] = hr; hs[(t * 64 + p) * 2 + 1] = hi_; }
                out[O_HRS + ((size_t)(l * DB + b) * NG + g) * SP + p] = hr; out[O_HIS + ((size_t)(l * DB + b) * NG + g) * SP + p] = hi_;
                LDS_WAIT(); asm volatile("" ::: "memory");
                const int t = lane >> 2, n4 = (lane & 3) * 4; float y[4] = {0.f, 0.f, 0.f, 0.f};
                const float* cr = A->in[21] + ((size_t)(l * NG + g) * GC + n4) * SP; const float* ci = A->in[22] + ((size_t)(l * NG + g) * GC + n4) * SP;
                for (int q = 0; q < SP; ++q) { const float xr = hs[(t * 64 + q) * 2], xi = hs[(t * 64 + q) * 2 + 1];
#pragma unroll
                    for (int k = 0; k < 4; ++k) y[k] += xr * cr[k * SP + q] - xi * ci[k * SP + q]; }
                u32x2 w; float yv[4];
#pragma unroll
                for (int k = 0; k < 4; ++k) yv[k] = geluf_(y[k] + A->in[23][l * D + g * GC + n4 + k] * ub[(size_t)t * D + n4 + k]);
                w.x = pk2bf(yv[0], yv[1]); w.y = pk2bf(yv[2], yv[3]);
                *(u32x2*)(YS + (size_t)(MP + b * DS + t) * D + g * GC + n4) = w;
                LDS_WAIT(); asm volatile("" ::: "memory");
            }
            __syncthreads();
            { const int c2 = split ? bx - DB * NH : vcu, G2 = split ? G - DB * NH : G;
              for (int un = c2; un < NG * 4; un += G2) tables_expand(lds, A, l, un, tid); }
            }
        }
#endif
        xcd_barrier(bar, wave0);

#if PH(4)
#if PH(13)
for (int rep_ = 0; rep_ < (l == 0 ? REPN(13) : 1); ++rep_)
        { PHASE_BEGIN
          pg8::Gemm g{WSP(bf16_t, WS_UX), WSP(bf16_t, WS_BT2), KX, KX, KX, (size_t)NPAIR * KX, (size_t)(LC * GC) * KX}; pg8::TileOrder S; S.init(2, 2, NG, G, bx);
          EpiS2 E{WSP(bf16_t, WS_YS)}; pg8::gemm_phase(lds, g, S, E, tid); }
#endif
#endif
        xcd_barrier(bar, wave0);
#if PH(5)
        {
            PHASE_BEGIN
            float* out = A->out;
            pg8::TileOrder TO; TO.init(MT / 256, D / 256, 1, G, 0);
            constexpr int NU = (MT / 256) * (D / 256);
#pragma unroll 1
            for (int r = 0; r * G + bx < 4 * NU; ++r) {
                int tid = wave0 * 64 + lane_id(); asm volatile("" : "+v"(tid));
                const int L = r * G + bx, type = L / NU; pg8::OneUnit S; TO.map(L % NU, S.u);
                const int pm = S.u.pm;
                pg8::Gemm g{nullptr, WSP(bf16_t, WS_WSM) + (size_t)(l * 4 + type) * D * D, D, D, D, 0, 0};
                if (type == 0) { g.A = WSP(bf16_t, WS_OA); EpiAP E{WSP(bf16_t, WS_GL), WSP(bf16_t, WS_MGA)}; pg8::gemm_phase(lds, g, S, E, tid); chain_signal(chain_cnt(ws, l, 0, pm), wave0 * 64 + lane_id()); }
                else if (type == 1) { g.A = WSP(bf16_t, WS_YS); EpiGLU E{WSP(bf16_t, WS_YS), WSP(bf16_t, WS_GS), A->in[25] + l * D, WSP(bf16_t, WS_Z)}; pg8::gemm_phase(lds, g, S, E, tid); chain_signal(chain_cnt(ws, l, 1, pm), wave0 * 64 + lane_id()); }
                else if (type == 2) { chain_wait(chain_cnt(ws, l, 0, pm), chain_cnt(ws, l, 1, pm), 4u, tid);
                    g.A = WSP(bf16_t, WS_Z); EpiSP E{WSP(bf16_t, WS_GL), WSP(bf16_t, WS_MGA), WSP(bf16_t, WS_MG)}; pg8::gemm_phase(lds, g, S, E, tid); chain_signal(chain_cnt(ws, l, 2, pm), wave0 * 64 + lane_id()); }
                else { chain_wait(chain_cnt(ws, l, 2, pm), nullptr, 4u, tid);
                    g.A = WSP(bf16_t, WS_MG); EpiOut E{WSP(bf16_t, WS_XB), out + O_Y, WSP(float, WS_SSQ), l + 1 < DEPTH ? 1 : 0}; pg8::gemm_phase(lds, g, S, E, tid); }
                __syncthreads();
            }
        }
#endif
        if (l + 1 < DEPTH) xcd_barrier(bar, wave0);
    }
}

extern "C" void kernel_launch(void* const* d_in, const int* in_sizes, int n_in, void* d_out, int out_size, void* d_ws, size_t ws_size, hipStream_t stream) {
    static int grid = 0;
    if (grid == 0) {
        if (n_in != 28 || out_size != (int)O_END || ws_size < WS_END) { fprintf(stderr, "kernel_launch: unexpected problem (n_in %d, out %d, ws %zu)\n", n_in, out_size, ws_size); grid = -1; return; }
        int dev = 0, cus = 0, per_cu = 0;
        if (hipGetDevice(&dev) != hipSuccess || hipDeviceGetAttribute(&cus, hipDeviceAttributeMultiprocessorCount, dev) != hipSuccess) { grid = -1; return; }
        if (hipFuncSetAttribute((const void*)mega_fwd, hipFuncAttributeMaxDynamicSharedMemorySize, LDS_BYTES) != hipSuccess) { fprintf(stderr, "kernel_launch: hipFuncSetAttribute failed\n"); grid = -1; return; }
        if (hipOccupancyMaxActiveBlocksPerMultiprocessor(&per_cu, (const void*)mega_fwd, NTHREADS, LDS_BYTES) != hipSuccess || per_cu < 1) { fprintf(stderr, "kernel_launch: occupancy query reports %d\n", per_cu); }
        (void)hipGetLastError();
        grid = cus;
    }
    if (grid < 0) return;
    (void)hipMemsetAsync((char*)d_ws + WS_CTL, 0, CTL_ZERO_BYTES, stream);
    Args a{};
    for (int i = 0; i < 28; ++i) a.in[i] = (const float*)d_in[i];
    a.out = (float*)d_out; a.ws = (unsigned char*)d_ws;
    hipLaunchKernelGGL(mega_fwd, dim3(grid), dim3(NTHREADS), LDS_BYTES, stream, a);
}
```
